# Optimizing an MI355X kernel written in HIP

```python
import math
import jax, jax.numpy as jnp
from jax import lax
import numpy as np

D_MODEL = 1024
BATCH = 32
SEQ = 2048
DEPTH = 2
DEC_BATCH = 16
DEC_SEQ = 4096
PAST_LEN = 128

N_MIXERS = 2
EPS = 1e-6
D_FF = 4 * D_MODEL
DA_HEADS = 8
DA_HEAD_DIM = D_MODEL // DA_HEADS // 2
DA_V_DIM = 2 * DA_HEAD_DIM
Q_BLOCK = 128
RET_HEADS = 4
RET_QK_DIM = D_MODEL // RET_HEADS
RET_V_DIM = 2 * D_MODEL // RET_HEADS
RET_CHUNK = 128

kernel_name = 'hybrid_diffattn_retention_encoder'

F32 = jnp.float32


def rms_norm(x, g):
    xf = x.astype(F32)
    y = xf * lax.rsqrt(jnp.mean(xf * xf, axis=-1, keepdims=True) + EPS)
    return (y * g.astype(F32)).astype(x.dtype)


def alibi_slopes(n):
    return jnp.asarray(np.array([2.0 ** (-8.0 * (h + 1) / n) for h in range(n)], dtype=np.float32))


def lambda_init_fn(layer_idx):
    return 0.8 - 0.6 * math.exp(-0.3 * layer_idx)


def diff_attention(x, w_in, w_out, lq1, lk1, lq2, lk2, g_sub, layer_idx):
    B, S, _ = x.shape
    H, d = DA_HEADS, DA_HEAD_DIM
    qkv = x @ w_in
    q, k, v = jnp.split(qkv, [H * 2 * d, 2 * H * 2 * d], axis=-1)
    q = q.reshape(B, S, H, 2, d) * (d ** -0.5)
    k = k.reshape(B, S, H, 2, d)
    v = v.reshape(B, S, H, DA_V_DIM)
    lam_init = lambda_init_fn(layer_idx)
    lam = (jnp.exp(jnp.sum(lq1.astype(F32) * lk1.astype(F32)))
           - jnp.exp(jnp.sum(lq2.astype(F32) * lk2.astype(F32))) + lam_init)
    slopes = alibi_slopes(H)
    kpos = jnp.arange(S, dtype=F32)
    nq = S // Q_BLOCK
    qb = q.reshape(B, nq, Q_BLOCK, H, 2, d).transpose(1, 0, 2, 3, 4, 5)

    def block(args):
        q_blk, bi = args
        qpos = (bi * Q_BLOCK + jnp.arange(Q_BLOCK)).astype(F32)
        bias = -slopes[:, None, None] * jnp.abs(qpos[:, None] - kpos[None, :])
        s = jnp.einsum('bqhcd,bkhcd->bhcqk', q_blk, k).astype(F32) + bias[None, :, None]
        p = jax.nn.softmax(s, axis=-1)
        w = p[:, :, 0] - lam * p[:, :, 1]
        return jnp.einsum('bhqk,bkhe->bqhe', w.astype(v.dtype), v)

    o = lax.map(block, (qb, jnp.arange(nq)))
    o = o.transpose(1, 0, 2, 3, 4).reshape(B, S, H, DA_V_DIM)
    o = rms_norm(o, g_sub) * (1.0 - lam_init)
    return o.reshape(B, S, H * DA_V_DIM) @ w_out


def retention_scan(q, k, v, log_gamma):
    B, S, H, dk = q.shape
    dv = v.shape[-1]
    C = RET_CHUNK
    N = S // C
    q = q.reshape(B, N, C, H, dk)
    k = k.reshape(B, N, C, H, dk)
    v = v.reshape(B, N, C, H, dv)
    idx = jnp.arange(C, dtype=F32)
    diff = idx[:, None] - idx[None, :]
    dmask = jnp.where(diff[None] >= 0,
                      jnp.exp(jnp.maximum(diff, 0.0)[None] * log_gamma[:, None, None]), 0.0)
    inner = jnp.einsum('bnihd,bnjhd->bnhij', q, k) * dmask[None, None]
    y_inner = jnp.einsum('bnhij,bnjhe->bnihe', inner, v)
    q_dec = q * jnp.exp((idx[:, None] + 1.0) * log_gamma[None, :])[:, :, None]
    k_dec = k * jnp.exp((C - 1.0 - idx)[:, None] * log_gamma[None, :])[:, :, None]
    chunk_decay = jnp.exp(C * log_gamma)[None, :, None, None]

    def step(state, xs):
        qn, kn, vn = xs
        y = jnp.einsum('bihd,bhde->bihe', qn, state)
        state = state * chunk_decay + jnp.einsum('bjhd,bjhe->bhde', kn, vn)
        return state, y

    init = jnp.zeros((B, H, dk, dv), F32)
    _, y_cross = lax.scan(step, init, (q_dec.swapaxes(0, 1), k_dec.swapaxes(0, 1), v.swapaxes(0, 1)))
    y = y_inner + y_cross.swapaxes(0, 1)
    return y.reshape(B, S, H, dv)


def retention(x, w_in, w_out, decay_fwd, decay_bwd, gn_w, gn_b):
    B, S, _ = x.shape
    H, dk, dv = RET_HEADS, RET_QK_DIM, RET_V_DIM
    proj = x @ w_in
    q, k, v, g = jnp.split(proj, [H * dk, 2 * H * dk, 2 * H * dk + H * dv], axis=-1)
    q = q.reshape(B, S, H, dk).astype(F32) * (dk ** -0.5)
    k = k.reshape(B, S, H, dk).astype(F32)
    v = v.reshape(B, S, H, dv).astype(F32)
    lg_f = jnp.log1p(-jnp.exp(decay_fwd.astype(F32)))
    lg_b = jnp.log1p(-jnp.exp(decay_bwd.astype(F32)))
    y_f = retention_scan(q, k, v, lg_f)
    y_b = retention_scan(q[:, ::-1], k[:, ::-1], v[:, ::-1], lg_b)[:, ::-1]
    y = y_f + y_b
    mu = jnp.mean(y, axis=-1, keepdims=True)
    yc = y - mu
    y = yc * lax.rsqrt(jnp.mean(yc * yc, axis=-1, keepdims=True) + EPS)
    y = y.reshape(B, S, H * dv) * gn_w.astype(F32) + gn_b.astype(F32)
    out = jax.nn.silu(g.astype(F32)) * y
    return out.astype(x.dtype) @ w_out


def squared_relu_mlp(x, w1, w2):
    return jnp.square(jax.nn.relu(x @ w1)) @ w2


def encoder_layer(x, layer_idx, norms, mixer_params, ffn_params):
    g_pre_mix, g_post_mix, g_pre_ffn, g_post_ffn = norms
    h = rms_norm(x, g_pre_mix)
    if layer_idx % N_MIXERS == 0:
        m = diff_attention(h, *mixer_params, layer_idx=layer_idx)
    else:
        m = retention(h, *mixer_params)
    x = x + rms_norm(m, g_post_mix)
    f = squared_relu_mlp(rms_norm(x, g_pre_ffn), *ffn_params)
    return x + rms_norm(f, g_post_ffn)


def setup_inputs(seed: int = 0) -> dict:
    key = jax.random.key(seed)
    ks = iter(jax.random.split(key, 48))

    def nrm(shape, scale):
        return jax.random.normal(next(ks), shape, F32) * scale

    def gain(n):
        return 1.0 + nrm((n,), 0.02)

    H_da, H_r = DA_HEADS, RET_HEADS
    ret_in = 2 * H_r * RET_QK_DIM + 2 * H_r * RET_V_DIM
    base_decay = (-5.0 - jnp.arange(H_r, dtype=F32)) * math.log(2.0)
    d = {}
    d['x_prompt'] = nrm((BATCH, SEQ, D_MODEL), 1.0)
    d['x_sample'] = nrm((DEC_BATCH, DEC_SEQ, D_MODEL), 1.0)
    d['l0_norm_pre_mix'] = gain(D_MODEL)
    d['l0_norm_post_mix'] = gain(D_MODEL)
    d['l0_norm_pre_ffn'] = gain(D_MODEL)
    d['l0_norm_post_ffn'] = gain(D_MODEL)
    d['l0_da_w_in'] = nrm((D_MODEL, 3 * H_da * 2 * DA_HEAD_DIM), D_MODEL ** -0.5)
    d['l0_da_w_out'] = nrm((H_da * DA_V_DIM, D_MODEL), (H_da * DA_V_DIM) ** -0.5)
    d['l0_da_lambda_q1'] = nrm((DA_HEAD_DIM,), 0.1)
    d['l0_da_lambda_k1'] = nrm((DA_HEAD_DIM,), 0.1)
    d['l0_da_lambda_q2'] = nrm((DA_HEAD_DIM,), 0.1)
    d['l0_da_lambda_k2'] = nrm((DA_HEAD_DIM,), 0.1)
    d['l0_da_subln'] = gain(DA_V_DIM)
    d['l0_ffn_w1'] = nrm((D_MODEL, D_FF), D_MODEL ** -0.5)
    d['l0_ffn_w2'] = nrm((D_FF, D_MODEL), D_FF ** -0.5)
    d['l1_norm_pre_mix'] = gain(D_MODEL)
    d['l1_norm_post_mix'] = gain(D_MODEL)
    d['l1_norm_pre_ffn'] = gain(D_MODEL)
    d['l1_norm_post_ffn'] = gain(D_MODEL)
    d['l1_ret_w_in'] = nrm((D_MODEL, ret_in), D_MODEL ** -0.5)
    d['l1_ret_w_out'] = nrm((H_r * RET_V_DIM, D_MODEL), (H_r * RET_V_DIM) ** -0.5)
    d['l1_ret_decay_fwd'] = base_decay + nrm((H_r,), 0.05)
    d['l1_ret_decay_bwd'] = base_decay + nrm((H_r,), 0.05)
    d['l1_ret_gn_w'] = gain(H_r * RET_V_DIM)
    d['l1_ret_gn_b'] = nrm((H_r * RET_V_DIM,), 0.02)
    d['l1_ffn_w1'] = nrm((D_MODEL, D_FF), D_MODEL ** -0.5)
    d['l1_ffn_w2'] = nrm((D_FF, D_MODEL), D_FF ** -0.5)
    return d


def reference(x_prompt, x_sample,
              l0_norm_pre_mix, l0_norm_post_mix, l0_norm_pre_ffn, l0_norm_post_ffn,
              l0_da_w_in, l0_da_w_out, l0_da_lambda_q1, l0_da_lambda_k1,
              l0_da_lambda_q2, l0_da_lambda_k2, l0_da_subln, l0_ffn_w1, l0_ffn_w2,
              l1_norm_pre_mix, l1_norm_post_mix, l1_norm_pre_ffn, l1_norm_post_ffn,
              l1_ret_w_in, l1_ret_w_out, l1_ret_decay_fwd, l1_ret_decay_bwd,
              l1_ret_gn_w, l1_ret_gn_b, l1_ffn_w1, l1_ffn_w2):
    layers = [
        ((l0_norm_pre_mix, l0_norm_post_mix, l0_norm_pre_ffn, l0_norm_post_ffn),
         (l0_da_w_in, l0_da_w_out, l0_da_lambda_q1, l0_da_lambda_k1,
          l0_da_lambda_q2, l0_da_lambda_k2, l0_da_subln),
         (l0_ffn_w1, l0_ffn_w2)),
        ((l1_norm_pre_mix, l1_norm_post_mix, l1_norm_pre_ffn, l1_norm_post_ffn),
         (l1_ret_w_in, l1_ret_w_out, l1_ret_decay_fwd, l1_ret_decay_bwd,
          l1_ret_gn_w, l1_ret_gn_b),
         (l1_ffn_w1, l1_ffn_w2)),
    ]

    def trunk(x):
        for i in range(DEPTH):
            norms, mixer_params, ffn_params = layers[i]
            x = encoder_layer(x, i, norms, mixer_params, ffn_params)
        return x

    y_prompt = trunk(x_prompt)
    y_sample = trunk(x_sample)
    return (y_prompt, y_sample)
```

```cpp
#include <hip/hip_runtime.h>
#include <hip/hip_cooperative_groups.h>
#include <cstdio>
namespace cg = cooperative_groups;

#define LAS __attribute__((address_space(3)))
#define DI __device__ __forceinline__
typedef unsigned short bf16_t;
typedef short bf16x8 __attribute__((ext_vector_type(8)));
typedef short s16x4 __attribute__((ext_vector_type(4)));
typedef float f32x4 __attribute__((ext_vector_type(4)));
typedef float f32x16 __attribute__((ext_vector_type(16)));
typedef unsigned u32x4 __attribute__((ext_vector_type(4)));
typedef unsigned u32x2 __attribute__((ext_vector_type(2)));

constexpr int TG = 32768;
constexpr int NGROUPS = 2;
constexpr int NPH = 18;
constexpr int LDS_BYTES = 153600;
constexpr float EPS = 1e-6f;
#ifndef PM
#define PM 63
#endif

constexpr size_t WT_IN0 = 0, WT_OUT0 = 6291456, WT_W10 = 8388608, WT_W20 = 16777216, WT_IN1 = 25165824, WT_OUT1 = 37748736,
                 WT_W11 = 41943040, WT_W21 = 50331648, HALF_BASE = 58720256, HALF_STRIDE = 469762048, BUF_A = 0, BUF_Y = 67108864, BUF_BIG = 201326592, WS_BAR = 998244352, WS_NORM = 998244352 + 256, WS_END = 998244352 + 256 + 16384;

struct Params {
    const float* in[27];
    float* out;
    unsigned char* ws;
    int ph_lo, ph_hi;
};

DI unsigned cvtpk(float lo, float hi) { unsigned r; asm volatile("v_cvt_pk_bf16_f32 %0, %1, %2" : "=v"(r) : "v"(lo), "v"(hi)); return r; }
DI float bf2f(unsigned short b) { return __uint_as_float(((unsigned)b) << 16); }
DI float bflo(unsigned w) { return __uint_as_float(w << 16); }
DI float bfhi(unsigned w) { return __uint_as_float(w & 0xffff0000u); }
DI float wave_sum(float v) {
#pragma unroll
    for (int o = 32; o; o >>= 1) v += __shfl_xor(v, o);
    return v;
}
DI int opaque_tid() { int t = threadIdx.x; asm volatile("" : "+v"(t)); return t; }
DI int crow(int r, int hi) { return (r & 3) + 8 * (r >> 2) + 4 * hi; }

namespace pg8 {
constexpr int BM = 256, BK = 64, HALF = 128, HTB = HALF * BK * 2, STAGE_BYTES = 8 * HTB, NXCD = 8, WGM = 8;
DI int lds_byte(int r, int c) { const int st = (r >> 4) * 2 + (c >> 5), rr = r & 15, cc = c & 31, ob = rr * 64 + cc * 2; return st * 1024 + (ob ^ (((ob >> 9) & 1) << 5)); }
DI void stage_rc(int b, int& R, int& C) { const int st = b / 1024, sb = b % 1024, swz = sb ^ (((sb >> 9) & 1) << 5); R = (st >> 1) * 16 + swz / 64; C = (st & 1) * 32 + (swz % 64) / 2; }
DI int perm32(int rho) { const int n = rho >> 4, i = rho & 15; return 8 * (i >> 2) + 4 * n + (i & 3); }
struct Unit { int pm, pn; };
struct Gemm { const bf16_t* A; const bf16_t* Bt; int M, N, K; };
struct StaticOrder {
    int nM, nN, nwg, G, c;
    DI void init(int M, int N, int G_, int c_) { nM = M / BM; nN = N / BM; nwg = nM * nN; G = G_; c = c_; }
    DI bool next(int i, Unit& u) const {
        const long L = (long)i * G + c; if (L >= nwg) return false;
        int wgid = (int)L; { const int q = nwg / NXCD, r = nwg % NXCD, xcd = wgid % NXCD, off = wgid / NXCD; wgid = (xcd < r ? xcd * (q + 1) : r * (q + 1) + (xcd - r) * q) + off; }
        const int nig = WGM * nN, gid = wgid / nig, fm = gid * WGM, gsz = (nM - fm) < WGM ? (nM - fm) : WGM;
        u.pm = fm + ((wgid % nig) % gsz); u.pn = (wgid % nig) / gsz; return true;
    }
};
struct EpiBf16R {
    static constexpr bool PERM = true;
    bf16_t* O; int ldc; int act;
    DI void operator()(const f32x4 (&acc)[2][2][4][2], const Unit& u, int wr, int wc, int fr, int fq) const {
        const int row0 = u.pm * BM + wr * 64 + fr; const int col0 = u.pn * BM + wc * 32 + 8 * fq;
#pragma unroll
        for (int ai = 0; ai < 2; ++ai)
#pragma unroll
            for (int m = 0; m < 4; ++m) { bf16_t* rowp = O + (size_t)(row0 + ai * HALF + m * 16) * ldc + col0;
#pragma unroll
                for (int bj = 0; bj < 2; ++bj) { f32x4 v0 = acc[ai][bj][m][0], v1 = acc[ai][bj][m][1];
                    if (act) {
#pragma unroll
                        for (int j = 0; j < 4; ++j) { float a = fmaxf(v0[j], 0.f), b = fmaxf(v1[j], 0.f); v0[j] = a * a; v1[j] = b * b; } }
                    u32x4 w; w.x = cvtpk(v0[0], v0[1]); w.y = cvtpk(v0[2], v0[3]); w.z = cvtpk(v1[0], v1[1]); w.w = cvtpk(v1[2], v1[3]);
                    *(u32x4*)(rowp + bj * HALF) = w; } }
    }
};

template <class Epi, class Sched>
DI void gemm_phase(LAS unsigned char* lds, const Gemm g, const Sched& S, const Epi& E) {
    const int tid = opaque_tid(), wid = __builtin_amdgcn_readfirstlane(tid >> 6), lane = tid & 63, wr = wid >> 2, wc = wid & 3, fr = lane & 15, fq = lane >> 4;
    const int K = g.K, nt = K / BK;
    unsigned voffA[2], voffB[2];
#pragma unroll
    for (int i = 0; i < 2; ++i) { int R, C; stage_rc(tid * 16 + i * 8192, R, C); const int Rb = Epi::PERM ? ((R & ~31) + perm32(R & 31)) : R;
        voffA[i] = (unsigned)(R * K + C) * 2u; voffB[i] = (unsigned)(Rb * K + C) * 2u; }
    const size_t kstep = (size_t)(BK * 2);
    const size_t hstep = (size_t)HALF * K * 2;
    const size_t tstep = 2 * hstep;
    const unsigned ldsw = (unsigned)wid * 1024u;
    const int aoff = lds_byte(wr * 64 + fr, fq * 8), boff = lds_byte(wc * 32 + fr, fq * 8);
#define PG8_SA(b, h) (((b) * 2 + (h)) * HTB)
#define PG8_SB(b, h) ((4 + (b) * 2 + (h)) * HTB)
#define PG8_STAGE(bufoff, gbase, voff) do { _Pragma("unroll") for (int _i = 0; _i < 2; ++_i) \
        __builtin_amdgcn_global_load_lds((const unsigned*)((const char*)(gbase) + (voff)[_i]), (LAS unsigned*)(lds + (bufoff) + ldsw + _i * 8192), 16, 0, 0); } while (0)
#define PG8_LDA(dst, b, h) do { _Pragma("unroll") for (int m = 0; m < 4; ++m) _Pragma("unroll") for (int k = 0; k < 2; ++k) dst[m][k] = *(const LAS bf16x8*)(lds + PG8_SA(b, h) + aoff + m * 2048 + k * 1024); } while (0)
#define PG8_LDB(dst, b, h) do { _Pragma("unroll") for (int n = 0; n < 2; ++n) _Pragma("unroll") for (int k = 0; k < 2; ++k) dst[n][k] = *(const LAS bf16x8*)(lds + PG8_SB(b, h) + boff + n * 2048 + k * 1024); } while (0)
#define PG8_MMA(ai, bj, At, Bt) do { __builtin_amdgcn_s_setprio(1); _Pragma("unroll") for (int m = 0; m < 4; ++m) _Pragma("unroll") for (int n = 0; n < 2; ++n) _Pragma("unroll") for (int k = 0; k < 2; ++k) \
        acc[ai][bj][m][n] = __builtin_amdgcn_mfma_f32_16x16x32_bf16(Bt[n][k], At[m][k], acc[ai][bj][m][n], 0, 0, 0); __builtin_amdgcn_s_setprio(0); } while (0)
#define PG8_WAIT_V(n) asm volatile("s_waitcnt vmcnt(" #n ")" ::: "memory")
#define PG8_WAIT_L(n) asm volatile("s_waitcnt lgkmcnt(" #n ")" ::: "memory")
#define PG8_BAR __builtin_amdgcn_s_barrier()
#define PG8_SCHED __builtin_amdgcn_sched_barrier(0)
    Unit cur, nxt; int ui = 0;
    if (!S.next(0, cur)) return;
    f32x4 acc[2][2][4][2];
#pragma unroll
    for (int a = 0; a < 2; ++a)
#pragma unroll
        for (int b = 0; b < 2; ++b)
#pragma unroll
            for (int m = 0; m < 4; ++m)
#pragma unroll
                for (int n = 0; n < 2; ++n) acc[a][b][m][n] = (f32x4){0.f, 0.f, 0.f, 0.f};
    bf16x8 At[4][2], B0[2][2], B1[2][2];
    const char* cA = (const char*)g.A + (size_t)cur.pm * tstep; const char* cB = (const char*)g.Bt + (size_t)cur.pn * tstep;
    PG8_STAGE(PG8_SB(0, 0), cB, voffB); PG8_STAGE(PG8_SA(0, 0), cA, voffA); PG8_STAGE(PG8_SB(0, 1), cB + hstep, voffB); PG8_STAGE(PG8_SA(0, 1), cA + hstep, voffA);
    if (wr == 1) PG8_BAR;
    PG8_WAIT_V(4); PG8_BAR;
    PG8_STAGE(PG8_SB(1, 0), cB + kstep, voffB); PG8_STAGE(PG8_SA(1, 0), cA + kstep, voffA); PG8_STAGE(PG8_SB(1, 1), cB + hstep + kstep, voffB);
    PG8_WAIT_V(6); PG8_BAR;
    for (;;) {
        const bool has_next = S.next(ui + 1, nxt);
        const char* nA = has_next ? (const char*)g.A + (size_t)nxt.pm * tstep : cA; const char* nB = has_next ? (const char*)g.Bt + (size_t)nxt.pn * tstep : cB;
        for (int t = 0; t < nt; t += 2) {
            const bool last = (t == nt - 2);
            const char* a1 = cA + (size_t)(t + 1) * kstep;
            const char* a2 = last ? nA : cA + (size_t)(t + 2) * kstep; const char* b2 = last ? nB : cB + (size_t)(t + 2) * kstep;
            const char* a3 = a2 + kstep; const char* b3 = b2 + kstep;
            PG8_LDB(B0, 0, 0); PG8_SCHED; PG8_LDA(At, 0, 0); PG8_STAGE(PG8_SA(1, 1), a1 + hstep, voffA);
            PG8_WAIT_L(8); PG8_BAR; PG8_WAIT_L(0); PG8_MMA(0, 0, At, B0); PG8_BAR; PG8_SCHED;
            PG8_LDB(B1, 0, 1); PG8_STAGE(PG8_SB(0, 0), b2, voffB);
            PG8_BAR; PG8_WAIT_L(0); PG8_MMA(0, 1, At, B1); PG8_BAR;
            PG8_LDA(At, 0, 1); PG8_STAGE(PG8_SA(0, 0), a2, voffA);
            PG8_BAR; PG8_WAIT_L(0); PG8_MMA(1, 0, At, B0); PG8_BAR; PG8_SCHED;
            PG8_STAGE(PG8_SB(0, 1), b2 + hstep, voffB);
            PG8_WAIT_V(6); PG8_BAR; PG8_MMA(1, 1, At, B1); PG8_BAR;
            PG8_LDB(B0, 1, 0); PG8_SCHED; PG8_LDA(At, 1, 0); PG8_STAGE(PG8_SA(0, 1), a2 + hstep, voffA);
            PG8_WAIT_L(8); PG8_BAR; PG8_WAIT_L(0); PG8_MMA(0, 0, At, B0); PG8_BAR; PG8_SCHED;
            PG8_LDB(B1, 1, 1); PG8_STAGE(PG8_SB(1, 0), b3, voffB);
            PG8_BAR; PG8_WAIT_L(0); PG8_MMA(0, 1, At, B1); PG8_BAR;
            PG8_LDA(At, 1, 1); PG8_STAGE(PG8_SA(1, 0), a3, voffA);
            PG8_BAR; PG8_WAIT_L(0); PG8_MMA(1, 0, At, B0); PG8_BAR; PG8_SCHED;
            PG8_STAGE(PG8_SB(1, 1), b3 + hstep, voffB);
            PG8_WAIT_V(6); PG8_BAR; PG8_MMA(1, 1, At, B1); PG8_BAR;
        }
        E(acc, cur, wr, wc, fr, fq);
        if (!has_next) break;
#pragma unroll
        for (int a = 0; a < 2; ++a)
#pragma unroll
            for (int b = 0; b < 2; ++b)
#pragma unroll
                for (int m = 0; m < 4; ++m)
#pragma unroll
                    for (int n = 0; n < 2; ++n) acc[a][b][m][n] = (f32x4){0.f, 0.f, 0.f, 0.f};
        cur = nxt; cA = nA; cB = nB; ++ui;
    }
    PG8_WAIT_V(0);
    if (wr == 0) PG8_BAR;
    PG8_BAR;
#undef PG8_SA
#undef PG8_SB
#undef PG8_STAGE
#undef PG8_LDA
#undef PG8_LDB
#undef PG8_MMA
#undef PG8_WAIT_V
#undef PG8_WAIT_L
#undef PG8_BAR
#undef PG8_SCHED
}
}

DI void wt_tiles(const float* __restrict__ W, bf16_t* __restrict__ Wt, int K, int N, LAS unsigned char* lds, int& tile_base) {
    LAS float* t = (LAS float*)lds;
    const int nk = K / 64, nn = N / 64, ntl = nk * nn, tid = opaque_tid();
    for (int tl = ((int)blockIdx.x - tile_base % (int)gridDim.x + (int)gridDim.x) % (int)gridDim.x; tl < ntl; tl += gridDim.x) {
        const int tk = tl / nn, tn = tl % nn;
        { const int kk = tid >> 3, c8 = (tid & 7) * 8; const float* src = W + (size_t)(tk * 64 + kk) * N + tn * 64 + c8;
          const f32x4 a = *(const f32x4*)src, b = *(const f32x4*)(src + 4);
          LAS float* d = t + kk * 65 + c8; d[0] = a[0]; d[1] = a[1]; d[2] = a[2]; d[3] = a[3]; d[4] = b[0]; d[5] = b[1]; d[6] = b[2]; d[7] = b[3]; }
        __syncthreads();
        { const int n = tid >> 3, k8 = (tid & 7) * 8; float v[8];
#pragma unroll
          for (int j = 0; j < 8; ++j) v[j] = t[(k8 + j) * 65 + n];
          u32x4 w; w.x = cvtpk(v[0], v[1]); w.y = cvtpk(v[2], v[3]); w.z = cvtpk(v[4], v[5]); w.w = cvtpk(v[6], v[7]);
          *(u32x4*)(Wt + (size_t)(tn * 64 + n) * K + tk * 64 + k8) = w; }
        __syncthreads();
    }
    tile_base += ntl;
}

DI void phase_row(const bf16_t* m, const float* xsrc, float* xdst, bf16_t* hn, const float* gpost, const float* gnext, int rows, int cb, int Gb) {
    const int tid_ = opaque_tid(); const int lane = tid_ & 63, wid = tid_ >> 6;
    const int nw = Gb * 8;
    for (int row0 = cb * 8 + wid; row0 < rows; row0 += 2 * nw) {
        const int rws[2] = {row0, row0 + nw < rows ? row0 + nw : row0};
        float x[2][16]; u32x4 mw[2][2];
#pragma unroll
        for (int q = 0; q < 2; ++q)
#pragma unroll
            for (int c = 0; c < 2; ++c) { const float* s = xsrc + (size_t)rws[q] * 1024 + c * 512 + lane * 8; const f32x4 a = *(const f32x4*)s, b = *(const f32x4*)(s + 4);
#pragma unroll
                for (int j = 0; j < 4; ++j) { x[q][c * 8 + j] = a[j]; x[q][c * 8 + 4 + j] = b[j]; } }
        if (m) {
#pragma unroll
            for (int q = 0; q < 2; ++q)
#pragma unroll
                for (int c = 0; c < 2; ++c) mw[q][c] = *(const u32x4*)(m + (size_t)rws[q] * 1024 + c * 512 + lane * 8);
            f32x4 ga[2], gb[2];
#pragma unroll
            for (int c = 0; c < 2; ++c) { const float* gp = gpost + c * 512 + lane * 8; ga[c] = *(const f32x4*)gp; gb[c] = *(const f32x4*)(gp + 4); }
#pragma unroll
            for (int q = 0; q < 2; ++q) {
                float mv[16]; float ss = 0.f;
#pragma unroll
                for (int c = 0; c < 2; ++c)
#pragma unroll
                    for (int j = 0; j < 4; ++j) { mv[c * 8 + 2 * j] = bflo(mw[q][c][j]); mv[c * 8 + 2 * j + 1] = bfhi(mw[q][c][j]); }
#pragma unroll
                for (int j = 0; j < 16; ++j) ss += mv[j] * mv[j];
                ss = wave_sum(ss);
                const float r = rsqrtf(ss * (1.f / 1024.f) + EPS);
#pragma unroll
                for (int c = 0; c < 2; ++c)
#pragma unroll
                    for (int j = 0; j < 4; ++j) { x[q][c * 8 + j] += mv[c * 8 + j] * r * ga[c][j]; x[q][c * 8 + 4 + j] += mv[c * 8 + 4 + j] * r * gb[c][j]; }
            }
        }
        if (xdst) {
#pragma unroll
            for (int q = 0; q < 2; ++q)
#pragma unroll
                for (int c = 0; c < 2; ++c) { float* d = xdst + (size_t)rws[q] * 1024 + c * 512 + lane * 8;
                    *(f32x4*)d = (f32x4){x[q][c * 8], x[q][c * 8 + 1], x[q][c * 8 + 2], x[q][c * 8 + 3]}; *(f32x4*)(d + 4) = (f32x4){x[q][c * 8 + 4], x[q][c * 8 + 5], x[q][c * 8 + 6], x[q][c * 8 + 7]}; }
        }
        if (hn) {
            f32x4 ga[2], gb[2];
#pragma unroll
            for (int c = 0; c < 2; ++c) { const float* gp = gnext + c * 512 + lane * 8; ga[c] = *(const f32x4*)gp; gb[c] = *(const f32x4*)(gp + 4); }
#pragma unroll
            for (int q = 0; q < 2; ++q) {
                float ss = 0.f;
#pragma unroll
                for (int j = 0; j < 16; ++j) ss += x[q][j] * x[q][j];
                ss = wave_sum(ss);
                const float r = rsqrtf(ss * (1.f / 1024.f) + EPS);
#pragma unroll
                for (int c = 0; c < 2; ++c) {
                    u32x4 w; w.x = cvtpk(x[q][c * 8] * r * ga[c][0], x[q][c * 8 + 1] * r * ga[c][1]); w.y = cvtpk(x[q][c * 8 + 2] * r * ga[c][2], x[q][c * 8 + 3] * r * ga[c][3]);
                    w.z = cvtpk(x[q][c * 8 + 4] * r * gb[c][0], x[q][c * 8 + 5] * r * gb[c][1]); w.w = cvtpk(x[q][c * 8 + 6] * r * gb[c][2], x[q][c * 8 + 7] * r * gb[c][3]);
                    *(u32x4*)(hn + (size_t)rws[q] * 1024 + c * 512 + lane * 8) = w; }
            }
        }
    }
}

DI void phase_gn(bf16_t* y, const bf16_t* big, const float* gw, const float* gb, int rows, int cb, int Gb) {
    const int tid_ = opaque_tid(); const int lane = tid_ & 63, wid = tid_ >> 6;
    for (int row = cb * 8 + wid; row < rows; row += Gb * 8) {
        u32x4 yw[4], gq[4];
#pragma unroll
        for (int hh = 0; hh < 4; ++hh) { yw[hh] = *(const u32x4*)(y + (size_t)row * 2048 + hh * 512 + lane * 8); gq[hh] = *(const u32x4*)(big + (size_t)row * 2048 + hh * 512 + lane * 8); }
#pragma unroll
        for (int hh = 0; hh < 4; ++hh) {
            bf16_t* yp = y + (size_t)row * 2048 + hh * 512 + lane * 8;
            float v[8], g[8];
#pragma unroll
            for (int j = 0; j < 4; ++j) { v[2 * j] = bflo(yw[hh][j]); v[2 * j + 1] = bfhi(yw[hh][j]); g[2 * j] = bflo(gq[hh][j]); g[2 * j + 1] = bfhi(gq[hh][j]); }
            float s = 0.f;
#pragma unroll
            for (int j = 0; j < 8; ++j) s += v[j];
            const float mu = wave_sum(s) * (1.f / 512.f);
            float q = 0.f;
#pragma unroll
            for (int j = 0; j < 8; ++j) { v[j] -= mu; q += v[j] * v[j]; }
            const float rs = rsqrtf(wave_sum(q) * (1.f / 512.f) + EPS);
            const float* wp = gw + hh * 512 + lane * 8; const float* bp = gb + hh * 512 + lane * 8;
            const f32x4 w0 = *(const f32x4*)wp, w1 = *(const f32x4*)(wp + 4), b0 = *(const f32x4*)bp, b1 = *(const f32x4*)(bp + 4);
            float o[8];
#pragma unroll
            for (int j = 0; j < 8; ++j) { const float wj = j < 4 ? w0[j & 3] : w1[j & 3], bj = j < 4 ? b0[j & 3] : b1[j & 3];
                const float sg = g[j] / (1.f + __expf(-g[j])); o[j] = sg * (v[j] * rs * wj + bj); }
            u32x4 ow; ow.x = cvtpk(o[0], o[1]); ow.y = cvtpk(o[2], o[3]); ow.z = cvtpk(o[4], o[5]); ow.w = cvtpk(o[6], o[7]);
            *(u32x4*)yp = ow;
        }
    }
}

DI void phase_norms(const bf16_t* __restrict__ qkv, unsigned* norms, int S, int cb, int Gb) {
    const int tid = opaque_tid(), lane = tid & 63, wid = tid >> 6;
    for (int chunk = cb * 8 + wid; chunk < TG / 32; chunk += Gb * 8) {
        const int t0 = chunk * 32, b = t0 / S;
        float q2 = 0.f, k2 = 0.f, nz = 0.f;
#pragma unroll 2
        for (int t = 0; t < 32; ++t) {
            const bf16_t* row = qkv + (size_t)(t0 + t) * 3072 + lane * 16;
            const u32x4 qa = *(const u32x4*)row, qb = *(const u32x4*)(row + 8), ka = *(const u32x4*)(row + 1024), kb = *(const u32x4*)(row + 1032);
            float sq = 0.f, sk = 0.f, sd = 0.f;
#pragma unroll
            for (int j = 0; j < 4; ++j) {
                { const float a = bflo(qa[j]), c = bfhi(qa[j]), d = bflo(ka[j]), e = bfhi(ka[j]); sq += a * a + c * c; sk += d * d + e * e; sd += a * d + c * e; }
                { const float a = bflo(qb[j]), c = bfhi(qb[j]), d = bflo(kb[j]), e = bfhi(kb[j]); sq += a * a + c * c; sk += d * d + e * e; sd += a * d + c * e; } }
            sq += __shfl_xor(sq, 1); sk += __shfl_xor(sk, 1); sd += __shfl_xor(sd, 1);
            sq += __shfl_xor(sq, 2); sk += __shfl_xor(sk, 2); sd += __shfl_xor(sd, 2);
            q2 = fmaxf(q2, sq); k2 = fmaxf(k2, sk); nz = fmaxf(nz, -sd * (0.125f * 1.4426950408889634f));
        }
        if ((lane & 3) == 0) { unsigned* n = norms + ((b * 8 + (lane >> 3)) * 2 + ((lane & 7) >> 2)) * 4;
            atomicMax(n, __float_as_uint(q2)); atomicMax(n + 1, __float_as_uint(k2)); atomicMax(n + 2, __float_as_uint(nz)); }
    }
}

namespace da {
constexpr int SHM_V = 64 * 128 * 2, SHM_K = 64 * 128 * 2, LDQ = 3072, LDK = 3072;
constexpr float C = 0.125f * 1.4426950408889634f;
constexpr float THRZ = 8.f * 1.4426950408889634f;
#define KSWZ(row, colB) ((row) * 256 + ((colB) ^ (((row) & 7) << 4)))
#define SBAR() __builtin_amdgcn_sched_barrier(0)

DI void partialSM(f32x16& p0, f32x16& p1, float& m_reg, float& mn, float& alpha, float tb, float nsl) {
#pragma unroll
    for (int r = 0; r < 16; ++r) { const float t0 = tb + (float)((r & 3) + 8 * (r >> 2)); const float t1 = t0 + 32.f;
        p0[r] = fmaf(p0[r], C, nsl * fabsf(t0)); p1[r] = fmaf(p1[r], C, nsl * fabsf(t1)); }
    float pmax = p0[0];
#pragma unroll
    for (int r = 1; r < 16; ++r) pmax = fmaxf(pmax, p0[r]);
#pragma unroll
    for (int r = 0; r < 16; ++r) pmax = fmaxf(pmax, p1[r]);
    { auto rr = __builtin_amdgcn_permlane32_swap(__float_as_uint(pmax), __float_as_uint(pmax), false, false);
      pmax = fmaxf(__uint_as_float(rr[0]), __uint_as_float(rr[1])); }
    if (__builtin_expect(__all(pmax - m_reg <= THRZ), 1)) { mn = m_reg; alpha = 1.f; }
    else { mn = fmaxf(m_reg, pmax); alpha = __builtin_amdgcn_exp2f(m_reg - mn); m_reg = mn; }
#pragma unroll
    for (int r = 0; r < 16; ++r) { p0[r] -= mn; p1[r] -= mn; }
#pragma unroll
    for (int r = 0; r < 16; ++r) p0[r] = __builtin_amdgcn_exp2f(p0[r]);
}
DI void partialSM_lin(f32x16& p0, f32x16& p1, float& m_reg, float& mn, float& alpha, float tb, float sgn_nsl) {
    asm volatile("" : "+v"(sgn_nsl));
#pragma unroll
    for (int r = 0; r < 16; ++r) { const float k = sgn_nsl * (float)((r & 3) + 8 * (r >> 2)); p0[r] = fmaf(p0[r], C, k); p1[r] = fmaf(p1[r], C, k); }
    float mx0 = p0[0], mx1 = p1[0];
#pragma unroll
    for (int r = 1; r < 16; ++r) { mx0 = fmaxf(mx0, p0[r]); mx1 = fmaxf(mx1, p1[r]); }
    const float base0 = sgn_nsl * tb, base1 = base0 + 32.f * sgn_nsl;
    float pmax = fmaxf(mx0 + base0, mx1 + base1);
    { auto rr = __builtin_amdgcn_permlane32_swap(__float_as_uint(pmax), __float_as_uint(pmax), false, false);
      pmax = fmaxf(__uint_as_float(rr[0]), __uint_as_float(rr[1])); }
    if (__builtin_expect(__all(pmax - m_reg <= THRZ), 1)) { mn = m_reg; alpha = 1.f; }
    else { mn = fmaxf(m_reg, pmax); alpha = __builtin_amdgcn_exp2f(m_reg - mn); m_reg = mn; }
    const float d0 = mn - base0, d1 = mn - base1;
#pragma unroll
    for (int r = 0; r < 16; ++r) { p0[r] -= d0; p1[r] -= d1; }
#pragma unroll
    for (int r = 0; r < 16; ++r) p0[r] = __builtin_amdgcn_exp2f(p0[r]);
}
DI void finishSM(f32x16& p0, f32x16& p1, float alpha, float& l_reg, bf16x8& pa0, bf16x8& pa1, bf16x8& pa2, bf16x8& pa3) {
#pragma unroll
    for (int r = 0; r < 16; ++r) p1[r] = __builtin_amdgcn_exp2f(p1[r]);
    float ps = 0;
#pragma unroll
    for (int r = 0; r < 16; ++r) ps += p0[r];
#pragma unroll
    for (int r = 0; r < 16; ++r) ps += p1[r];
    { auto rr = __builtin_amdgcn_permlane32_swap(__float_as_uint(ps), __float_as_uint(ps), false, false);
      ps = __uint_as_float(rr[0]) + __uint_as_float(rr[1]); }
    l_reg = l_reg * alpha + ps;
#define PK4(P, BASE, OUT) do { unsigned a0 = cvtpk(P[BASE + 0], P[BASE + 1]), a1 = cvtpk(P[BASE + 2], P[BASE + 3]);   \
    unsigned b0 = cvtpk(P[BASE + 4], P[BASE + 5]), b1 = cvtpk(P[BASE + 6], P[BASE + 7]);                              \
    auto r0 = __builtin_amdgcn_permlane32_swap(a0, b0, false, false); auto r1 = __builtin_amdgcn_permlane32_swap(a1, b1, false, false); \
    u32x4 w = {r0[0], r1[0], r0[1], r1[1]}; OUT = __builtin_bit_cast(bf16x8, w); } while (0)
    PK4(p0, 0, pa0); PK4(p0, 8, pa1); PK4(p1, 0, pa2); PK4(p1, 8, pa3);
#undef PK4
}
DI void qkt(f32x16& p0, f32x16& p1, const LAS unsigned char* Ks, const bf16x8* qr, int r32, int hi, int cmap) {
#pragma unroll
    for (int r = 0; r < 16; ++r) { p0[r] = 0.f; p1[r] = 0.f; }
#pragma unroll
    for (int d0 = 0; d0 < 4; ++d0) { const int cb = (cmap * 64 + d0 * 16 + hi * 8) * 2;
        const bf16x8 b0 = *(const LAS bf16x8*)(Ks + KSWZ(r32, cb));
        const bf16x8 b1 = *(const LAS bf16x8*)(Ks + KSWZ(32 + r32, cb));
        p0 = __builtin_amdgcn_mfma_f32_32x32x16_bf16(b0, qr[d0], p0, 0, 0, 0);
        p1 = __builtin_amdgcn_mfma_f32_32x32x16_bf16(b1, qr[d0], p1, 0, 0, 0); }
}
DI int v_st(int k, int c) { const int kk = (k & ~0xC) | ((k & 4) << 1) | ((k & 8) >> 1); return ((kk >> 3) * 4 + (c >> 5)) * 512 + ((kk & 7) * 32 + (c & 31)) * 2; }
DI int v_rd_base(int lane) { return ((lane & 3) << 3) | (((lane >> 2) & 3) << 6) | (((lane >> 4) & 1) << 5) | (((lane >> 5) & 1) << 8); }
constexpr int v_rd_off(int d0, int ks, int half) { return d0 * 512 + ks * 4096 + half * 2048; }
template <int OFF> DI s16x4 tr_read(int vb) { s16x4 r; asm volatile("ds_read_b64_tr_b16 %0, %1 offset:%2" : "=&v"(r) : "v"(vb), "i"(OFF) : "memory"); return r; }
template <int D0> DI void pv_one(f32x16& od, int vb, bf16x8 pa0, bf16x8 pa1, bf16x8 pa2, bf16x8 pa3) {
    const s16x4 l0 = tr_read<v_rd_off(D0, 0, 0)>(vb), h0 = tr_read<v_rd_off(D0, 0, 1)>(vb), l1 = tr_read<v_rd_off(D0, 1, 0)>(vb), h1 = tr_read<v_rd_off(D0, 1, 1)>(vb);
    const s16x4 l2 = tr_read<v_rd_off(D0, 2, 0)>(vb), h2 = tr_read<v_rd_off(D0, 2, 1)>(vb), l3 = tr_read<v_rd_off(D0, 3, 0)>(vb), h3 = tr_read<v_rd_off(D0, 3, 1)>(vb);
    asm volatile("s_waitcnt lgkmcnt(0)" ::: "memory"); SBAR();
#define PK(L, H) (bf16x8){L[0], L[1], L[2], L[3], H[0], H[1], H[2], H[3]}
    od = __builtin_amdgcn_mfma_f32_32x32x16_bf16(pa0, PK(l0, h0), od, 0, 0, 0);
    od = __builtin_amdgcn_mfma_f32_32x32x16_bf16(pa1, PK(l1, h1), od, 0, 0, 0);
    od = __builtin_amdgcn_mfma_f32_32x32x16_bf16(pa2, PK(l2, h2), od, 0, 0, 0);
    od = __builtin_amdgcn_mfma_f32_32x32x16_bf16(pa3, PK(l3, h3), od, 0, 0, 0);
#undef PK
}
DI void pv_d0(f32x16* o, int vb, bf16x8 pa0, bf16x8 pa1, bf16x8 pa2, bf16x8 pa3) {
    pv_one<0>(o[0], vb, pa0, pa1, pa2, pa3); pv_one<1>(o[1], vb, pa0, pa1, pa2, pa3); pv_one<2>(o[2], vb, pa0, pa1, pa2, pa3); pv_one<3>(o[3], vb, pa0, pa1, pa2, pa3);
}

DI void attn_item(const bf16_t* __restrict__ Qb, const bf16_t* __restrict__ Kh, const bf16_t* __restrict__ Vh, bf16_t* __restrict__ Ob,
                  int q0, int tile0, int ntiles, float nsl, float lam, const float* __restrict__ gsub, LAS unsigned char* lds) {
    const int tid = opaque_tid(), wid = tid >> 6, lane = tid & 63, r32 = lane & 31, hi = lane >> 5;
    const int pair = wid >> 1, cmap = wid & 1;
    Kh += (long)tile0 * 64 * LDK; Vh += (long)tile0 * 64 * LDK;
    LAS unsigned char* V_lds = lds; LAS unsigned char* K_lds = lds + 2 * SHM_V;
    LAS float* wsf = (LAS float*)(lds + 2 * SHM_V + 2 * SHM_K) + wid * 64; LAS float* li_l = wsf; LAS float* al_l = wsf + 32;
    float m_reg = -1e30f, l_reg = 0.f; f32x16 o[4]; bf16x8 qr[4];
#pragma unroll
    for (int d = 0; d < 4; ++d)
#pragma unroll
        for (int r = 0; r < 16; ++r) o[d][r] = 0.f;
    const bf16_t* Qw = Qb + (long)(pair * 32 + r32) * LDQ + cmap * 64 + hi * 8;
#pragma unroll
    for (int d0 = 0; d0 < 4; ++d0) qr[d0] = *(const bf16x8*)(Qw + d0 * 16);
    const float tq = 4.f * (float)hi - (float)(q0 + pair * 32 + r32) + (float)(tile0 * 64);
    const int sr = tid >> 4, sc = (tid & 15) * 8, vst0 = v_st(sr, sc), vst1 = v_st(32 + sr, sc);
    const int vb0 = (int)(unsigned)(size_t)V_lds + v_rd_base(lane);
    bf16x8 vs0, vs1, ks0, ks1;
#define SLOAD(k0) do { vs0 = *(const bf16x8*)(&Vh[(long)((k0) + sr) * LDK + sc]); vs1 = *(const bf16x8*)(&Vh[(long)((k0) + 32 + sr) * LDK + sc]); \
    ks0 = *(const bf16x8*)(&Kh[(long)((k0) + sr) * LDK + sc]); ks1 = *(const bf16x8*)(&Kh[(long)((k0) + 32 + sr) * LDK + sc]); } while (0)
#define SWRITE(b) do { *(LAS bf16x8*)(V_lds + (b) * SHM_V + vst0) = vs0; *(LAS bf16x8*)(V_lds + (b) * SHM_V + vst1) = vs1; const int kc = sc * 2; \
    *(LAS bf16x8*)(K_lds + (b) * SHM_K + KSWZ(sr, kc)) = ks0; *(LAS bf16x8*)(K_lds + (b) * SHM_K + KSWZ(32 + sr, kc)) = ks1; } while (0)
#define RESC(a) do { if (__any((a) < 1.f)) { if (hi == 0) al_l[r32] = (a); asm volatile("s_waitcnt lgkmcnt(0)" ::: "memory"); \
    _Pragma("unroll") for (int d = 0; d < 4; ++d) _Pragma("unroll") for (int r = 0; r < 16; ++r) o[d][r] *= al_l[crow(r, hi)]; } } while (0)
    f32x16 pA0, pA1, pB0, pB1; float mnA, mnB, alA, alB; bf16x8 pa0, pa1, pa2, pa3; const int NT = ntiles;
    const int dlo = (q0 >> 6) - tile0;
#define PSM(P0, P1, MN, AL, JR) do { const int jr_ = (JR); const float tb_ = tq + (float)(jr_ * 64); \
        if (jr_ < dlo || jr_ > dlo + 1) partialSM_lin(P0, P1, m_reg, MN, AL, tb_, jr_ < dlo ? -nsl : nsl); \
        else partialSM(P0, P1, m_reg, MN, AL, tb_, nsl); } while (0)
    SLOAD(0); SWRITE(0); __syncthreads();
    qkt(pA0, pA1, K_lds, qr, r32, hi, cmap); PSM(pA0, pA1, mnA, alA, 0);
    SLOAD(64); SWRITE(1); __syncthreads();
    for (int j = 1; j + 1 < NT; j += 2) {
        SBAR(); qkt(pB0, pB1, K_lds + SHM_K, qr, r32, hi, cmap);
        finishSM(pA0, pA1, alA, l_reg, pa0, pa1, pa2, pa3); SBAR();
        SLOAD((j + 1) * 64); SBAR();
        pv_d0(o, vb0, pa0, pa1, pa2, pa3); PSM(pB0, pB1, mnB, alB, j);
        __syncthreads(); SWRITE(0);
        RESC(alB); __syncthreads();
        SBAR(); qkt(pA0, pA1, K_lds, qr, r32, hi, cmap);
        finishSM(pB0, pB1, alB, l_reg, pa0, pa1, pa2, pa3); SBAR();
        SLOAD((j + 2) * 64); SBAR();
        pv_d0(o, vb0 + SHM_V, pa0, pa1, pa2, pa3); PSM(pA0, pA1, mnA, alA, j + 1);
        __syncthreads(); SWRITE(1);
        RESC(alA); __syncthreads();
    }
    SBAR(); qkt(pB0, pB1, K_lds + SHM_K, qr, r32, hi, cmap);
    finishSM(pA0, pA1, alA, l_reg, pa0, pa1, pa2, pa3); SBAR();
    pv_d0(o, vb0, pa0, pa1, pa2, pa3); PSM(pB0, pB1, mnB, alB, NT - 1);
    __syncthreads(); RESC(alB);
    finishSM(pB0, pB1, alB, l_reg, pa0, pa1, pa2, pa3); SBAR();
    pv_d0(o, vb0 + SHM_V, pa0, pa1, pa2, pa3);
    if (hi == 0) li_l[r32] = l_reg; asm volatile("s_waitcnt lgkmcnt(0)" ::: "memory");
    float rli[16];
    const float msc = cmap ? -lam : 1.f;
#pragma unroll
    for (int r = 0; r < 16; ++r) rli[r] = __builtin_amdgcn_rcpf(li_l[crow(r, hi)]) * msc;
    __syncthreads();
    LAS float* Obuf = (LAS float*)lds;
    if (cmap == 1) {
#pragma unroll
        for (int d0 = 0; d0 < 4; ++d0)
#pragma unroll
            for (int r = 0; r < 16; ++r) Obuf[(pair * 32 + crow(r, hi)) * 128 + d0 * 32 + r32] = o[d0][r] * rli[r];
    }
    __syncthreads();
    if (cmap == 0) {
#pragma unroll
        for (int d0 = 0; d0 < 4; ++d0)
#pragma unroll
            for (int r = 0; r < 16; ++r) Obuf[(pair * 32 + crow(r, hi)) * 128 + d0 * 32 + r32] += o[d0][r] * rli[r];
    }
    __syncthreads();
    { const int row = tid >> 2, qt = tid & 3; const LAS float* src = Obuf + row * 128 + qt * 32; float v[32]; float ss = 0.f;
#pragma unroll
      for (int j = 0; j < 8; ++j) { const f32x4 t = *(const LAS f32x4*)(src + 4 * j); v[4 * j] = t[0]; v[4 * j + 1] = t[1]; v[4 * j + 2] = t[2]; v[4 * j + 3] = t[3]; }
#pragma unroll
      for (int j = 0; j < 32; ++j) ss += v[j] * v[j];
      ss += __shfl_xor(ss, 1); ss += __shfl_xor(ss, 2);
      const float rs = rsqrtf(ss * (1.f / 128.f) + EPS) * 0.8f;
      bf16_t* dst = Ob + (long)row * 1024 + qt * 32;
#pragma unroll
      for (int j = 0; j < 4; ++j) { const f32x4 g0 = *(const f32x4*)(gsub + qt * 32 + 8 * j), g1 = *(const f32x4*)(gsub + qt * 32 + 8 * j + 4);
          u32x4 w; w.x = cvtpk(v[8 * j] * rs * g0[0], v[8 * j + 1] * rs * g0[1]); w.y = cvtpk(v[8 * j + 2] * rs * g0[2], v[8 * j + 3] * rs * g0[3]);
          w.z = cvtpk(v[8 * j + 4] * rs * g1[0], v[8 * j + 5] * rs * g1[1]); w.w = cvtpk(v[8 * j + 6] * rs * g1[2], v[8 * j + 7] * rs * g1[3]);
          *(u32x4*)(dst + 8 * j) = w; } }
    __syncthreads();
#undef SLOAD
#undef SWRITE
#undef RESC
#undef PSM
}
}

namespace rt {
constexpr int KP = 528, VP = 144, SP = 528;
constexpr int KIMG = 0, VIMG = 128 * KP, SIMG = VIMG + 128 * VP, LDS_END = SIMG + 2 * 64 * SP;
static_assert(LDS_END <= LDS_BYTES, "retention LDS");
DI s16x4 trr(LAS unsigned char* p) { return __builtin_amdgcn_ds_read_tr16_b64_v4i16((LAS s16x4*)p); }
#define CAT8(L, H) (bf16x8){L[0], L[1], L[2], L[3], H[0], H[1], H[2], H[3]}

#define LBAR() do { asm volatile("s_waitcnt lgkmcnt(0)" ::: "memory"); __builtin_amdgcn_s_barrier(); asm volatile("" ::: "memory"); } while (0)
DI void ret_item(const bf16_t* __restrict__ P, bf16_t* __restrict__ Y, int S, int h, int sl, float lgf, float lgb, LAS unsigned char* lds) {
    const int tid = opaque_tid(), wid = tid >> 6, lane = tid & 63, r = lane & 31, h2 = lane >> 5;
    const int l15 = lane & 15, quad = lane >> 4, i0 = wid * 16, db = wid;
    const int gsub = (lane >> 4) & 1, tq = l15 >> 2, tp = l15 & 3;
    const int N = S / 128;
    bf16_t* Yl = Y + h * 512 + sl * 64 + l15;
    const bf16_t* Pq = P + (long)(i0 + l15) * 4096 + h * 256 + 8 * quad;
    const bf16_t* Pk = P + (long)(tid >> 5) * 4096 + 1024 + h * 256 + (tid & 31) * 8;
    const bf16_t* Pv = P + (long)(tid >> 3) * 4096 + 2048 + h * 512 + sl * 64 + (tid & 7) * 8;
#pragma unroll 1
    for (int dir = 0; dir < 2; ++dir) {
        const float lg = dir ? lgb : lgf;
        f32x16 st0, st1;
#pragma unroll
        for (int i = 0; i < 16; ++i) { st0[i] = 0.f; st1[i] = 0.f; }
        __syncthreads();
        for (int i = tid; i < 64 * SP / 16; i += 512) *(LAS u32x4*)(lds + SIMG + i * 16) = (u32x4){0u, 0u, 0u, 0u};
        const float cd = __builtin_amdgcn_exp2f(128.f * lg);
        bf16x8 qf[8], kr[8]; u32x4 vr[2];
#define RLOAD(n_) do { const long tk = (long)(n_) * 128 * 4096; \
            _Pragma("unroll") for (int s = 0; s < 8; ++s) qf[s] = *(const bf16x8*)(Pq + tk + 32 * s); \
            _Pragma("unroll") for (int i = 0; i < 8; ++i) kr[i] = *(const bf16x8*)(Pk + tk + (long)i * 16 * 4096); \
            _Pragma("unroll") for (int i = 0; i < 2; ++i) vr[i] = *(const u32x4*)(Pv + tk + (long)i * 64 * 4096); } while (0)
        RLOAD(dir ? N - 1 : 0);
        LBAR();
#pragma unroll 1
        for (int nn = 0; nn < N; ++nn) {
            const int n = dir ? N - 1 - nn : nn;
            const long tok0 = (long)n * 128;
            const int scur = SIMG + (nn & 1) * (64 * SP), snxt = SIMG + ((nn + 1) & 1) * (64 * SP);
            f32x4 yc[4];
#pragma unroll
            for (int nb = 0; nb < 4; ++nb) yc[nb] = (f32x4){0.f, 0.f, 0.f, 0.f};
            {
                const LAS unsigned char* sb = lds + scur + l15 * SP + 16 * quad;
                bf16x8 Bc[4], Bn[4];
#pragma unroll
                for (int nb = 0; nb < 4; ++nb) Bc[nb] = *(const LAS bf16x8*)(sb + 16 * nb * SP);
#pragma unroll
                for (int s = 0; s < 8; ++s) {
                    if (s < 7) {
#pragma unroll
                        for (int nb = 0; nb < 4; ++nb) Bn[nb] = *(const LAS bf16x8*)(sb + 16 * nb * SP + 64 * (s + 1)); }
                    __builtin_amdgcn_sched_barrier(0);
#pragma unroll
                    for (int nb = 0; nb < 4; ++nb) yc[nb] = __builtin_amdgcn_mfma_f32_16x16x32_bf16(qf[s], Bc[nb], yc[nb], 0, 0, 0);
                    __builtin_amdgcn_sched_barrier(0);
#pragma unroll
                    for (int nb = 0; nb < 4; ++nb) Bc[nb] = Bn[nb];
                }
            }
#pragma unroll
            for (int jj = 0; jj < 4; ++jj) { const int i = i0 + 4 * quad + jj; const float qd = 0.0625f * __builtin_amdgcn_exp2f(lg * (float)(dir ? 128 - i : i + 1));
#pragma unroll
                for (int nb = 0; nb < 4; ++nb) yc[nb][jj] *= qd; }
#pragma unroll
            for (int i = 0; i < 8; ++i) *(LAS bf16x8*)(lds + KIMG + ((tid >> 5) + 16 * i) * KP + (tid & 31) * 16) = kr[i];
#pragma unroll
            for (int i = 0; i < 2; ++i) { const int row = (tid >> 3) + 64 * i; const u32x4 w = vr[i];
                const float kd = __builtin_amdgcn_exp2f(lg * (float)(dir ? row : 127 - row));
                u32x4 o; o.x = cvtpk(bflo(w.x) * kd, bfhi(w.x) * kd); o.y = cvtpk(bflo(w.y) * kd, bfhi(w.y) * kd);
                o.z = cvtpk(bflo(w.z) * kd, bfhi(w.z) * kd); o.w = cvtpk(bflo(w.w) * kd, bfhi(w.w) * kd);
                *(LAS u32x4*)(lds + VIMG + row * VP + (tid & 7) * 16) = o; }
            LBAR();
            if (dir == 1) {
                float yf[16];
#pragma unroll
                for (int nb = 0; nb < 4; ++nb)
#pragma unroll
                    for (int jj = 0; jj < 4; ++jj) yf[nb * 4 + jj] = bf2f(Yl[(tok0 + i0 + 4 * quad + jj) * 2048 + 16 * nb]);
                const int i = i0 + l15;
#pragma unroll 1
                for (int t = 0; t < 4; ++t) {
                    f32x4 sc0 = (f32x4){0.f, 0.f, 0.f, 0.f}, sc1 = (f32x4){0.f, 0.f, 0.f, 0.f};
#pragma unroll
                    for (int s = 0; s < 8; ++s) {
                        const bf16x8 A0 = *(const LAS bf16x8*)(lds + KIMG + (32 * t + l15) * KP + (32 * s + 8 * quad) * 2);
                        const bf16x8 A1 = *(const LAS bf16x8*)(lds + KIMG + (32 * t + 16 + l15) * KP + (32 * s + 8 * quad) * 2);
                        sc0 = __builtin_amdgcn_mfma_f32_16x16x32_bf16(A0, qf[s], sc0, 0, 0, 0);
                        sc1 = __builtin_amdgcn_mfma_f32_16x16x32_bf16(A1, qf[s], sc1, 0, 0, 0);
                        if ((s & 3) == 3) __builtin_amdgcn_sched_barrier(0); }
#pragma unroll
                    for (int jj = 0; jj < 4; ++jj) {
                        { const int j = 32 * t + 4 * quad + jj; const float a = (i > j) ? ((float)(i - j) * lgf - (float)j * lgb) : (-(float)i * lgb);
                          float w = __builtin_amdgcn_exp2f(a) * 0.0625f; if (i == j) w *= 2.f; sc0[jj] *= w; }
                        { const int j = 32 * t + 16 + 4 * quad + jj; const float a = (i > j) ? ((float)(i - j) * lgf - (float)j * lgb) : (-(float)i * lgb);
                          float w = __builtin_amdgcn_exp2f(a) * 0.0625f; if (i == j) w *= 2.f; sc1[jj] *= w; } }
                    u32x4 pw; pw.x = cvtpk(sc0[0], sc0[1]); pw.y = cvtpk(sc0[2], sc0[3]); pw.z = cvtpk(sc1[0], sc1[1]); pw.w = cvtpk(sc1[2], sc1[3]);
#pragma unroll
                    for (int nb = 0; nb < 4; ++nb) {
                        LAS unsigned char* vb = lds + VIMG + (32 * t + 4 * quad + tq) * VP + (16 * nb) * 2 + 8 * tp;
                        const s16x4 lo = trr(vb), hi = trr(vb + 16 * VP);
                        yc[nb] = __builtin_amdgcn_mfma_f32_16x16x32_bf16(__builtin_bit_cast(bf16x8, pw), CAT8(lo, hi), yc[nb], 0, 0, 0); }
                }
#pragma unroll
                for (int nb = 0; nb < 4; ++nb)
#pragma unroll
                    for (int jj = 0; jj < 4; ++jj) yc[nb][jj] += yf[nb * 4 + jj];
            }
#pragma unroll
            for (int nb = 0; nb < 4; ++nb)
#pragma unroll
                for (int jj = 0; jj < 4; ++jj) Yl[(tok0 + i0 + 4 * quad + jj) * 2048 + 16 * nb] = (bf16_t)(cvtpk(yc[nb][jj], 0.f) & 0xffffu);
            if (nn + 1 < N) RLOAD(dir ? n - 1 : n + 1);
#pragma unroll
            for (int i = 0; i < 16; ++i) { st0[i] *= cd; st1[i] *= cd; }
#pragma unroll 2
            for (int s = 0; s < 8; ++s) {
                LAS unsigned char* ka = lds + KIMG + (16 * s + 8 * h2 + tq) * KP + (db * 32 + 16 * gsub) * 2 + 8 * tp;
                LAS unsigned char* va = lds + VIMG + (16 * s + 8 * h2 + tq) * VP + (16 * gsub) * 2 + 8 * tp;
                const s16x4 alo = trr(ka), ahi = trr(ka + 4 * KP);
                const s16x4 b0lo = trr(va), b0hi = trr(va + 4 * VP), b1lo = trr(va + 64), b1hi = trr(va + 4 * VP + 64);
                const bf16x8 A = CAT8(alo, ahi);
                st0 = __builtin_amdgcn_mfma_f32_32x32x16_bf16(A, CAT8(b0lo, b0hi), st0, 0, 0, 0);
                st1 = __builtin_amdgcn_mfma_f32_32x32x16_bf16(A, CAT8(b1lo, b1hi), st1, 0, 0, 0); }
#pragma unroll
            for (int g = 0; g < 4; ++g) {
                u32x2 w0, w1; w0.x = cvtpk(st0[4 * g], st0[4 * g + 1]); w0.y = cvtpk(st0[4 * g + 2], st0[4 * g + 3]); w1.x = cvtpk(st1[4 * g], st1[4 * g + 1]); w1.y = cvtpk(st1[4 * g + 2], st1[4 * g + 3]);
                *(LAS u32x2*)(lds + snxt + r * SP + (db * 32 + 8 * g + 4 * h2) * 2) = w0;
                *(LAS u32x2*)(lds + snxt + (32 + r) * SP + (db * 32 + 8 * g + 4 * h2) * 2) = w1; }
            LBAR();
        }
#undef RLOAD
    }
    __syncthreads();
}
}

DI void grid_barrier(unsigned* ctr, unsigned target) {
    __syncthreads();
    if (threadIdx.x == 0) {
        __builtin_amdgcn_fence(__ATOMIC_RELEASE, "agent");
        asm volatile("s_waitcnt vmcnt(0)" ::: "memory");
        __hip_atomic_fetch_add(ctr, 1u, __ATOMIC_RELAXED, __HIP_MEMORY_SCOPE_AGENT);
        while (__hip_atomic_load(ctr, __ATOMIC_RELAXED, __HIP_MEMORY_SCOPE_AGENT) < target) __builtin_amdgcn_s_sleep(2);
        __builtin_amdgcn_fence(__ATOMIC_ACQUIRE, "agent");
        asm volatile("s_waitcnt vmcnt(0)" ::: "memory");
    }
    __syncthreads();
}

__global__ __launch_bounds__(512, 2) void mega(Params p) {
    extern __shared__ __attribute__((aligned(16))) unsigned char shm[];
    LAS unsigned char* lds = (LAS unsigned char*)shm;
    cg::grid_group grid = cg::this_grid();
    unsigned* barctr = (unsigned*)(p.ws + WS_BAR); unsigned nbar = 0;
    const int G = gridDim.x, bid = blockIdx.x;
    const int half = (bid >> 3) & 1, c = ((bid >> 4) << 3) | (bid & 7), Gh = G >> 1;
    const int vid = (c & 7) * (Gh >> 3) + (c >> 3);
    unsigned char* ws = p.ws;
    unsigned char* hb = ws + HALF_BASE + (size_t)half * HALF_STRIDE;
    bf16_t* bufA = (bf16_t*)(hb + BUF_A); bf16_t* bufY = (bf16_t*)(hb + BUF_Y); bf16_t* bufBig = (bf16_t*)(hb + BUF_BIG);
    unsigned* normw = (unsigned*)(ws + WS_NORM) + half * 2048;
    const int nph = NGROUPS * NPH;
    if (p.ph_lo < 0) grid.sync();
    for (int ph = p.ph_lo; ph < p.ph_hi && ph < nph; ++ph) {
        if (ph == 0) {
          if (PM & 1) {
            int tb = 0;
            wt_tiles(p.in[6], (bf16_t*)(ws + WT_IN0), 1024, 3072, lds, tb);
            wt_tiles(p.in[7], (bf16_t*)(ws + WT_OUT0), 1024, 1024, lds, tb);
            wt_tiles(p.in[13], (bf16_t*)(ws + WT_W10), 1024, 4096, lds, tb);
            wt_tiles(p.in[14], (bf16_t*)(ws + WT_W20), 4096, 1024, lds, tb);
            wt_tiles(p.in[19], (bf16_t*)(ws + WT_IN1), 1024, 6144, lds, tb);
            wt_tiles(p.in[20], (bf16_t*)(ws + WT_OUT1), 2048, 1024, lds, tb);
            wt_tiles(p.in[25], (bf16_t*)(ws + WT_W11), 1024, 4096, lds, tb);
            wt_tiles(p.in[26], (bf16_t*)(ws + WT_W21), 4096, 1024, lds, tb);
          }
        }
        {
            const int g = ph / NPH, s = ph % NPH;
            const int smp = half == 0 ? g : 1 - g;
            const float* xin = (smp ? p.in[1] : p.in[0]) + (size_t)half * TG * 1024;
            float* xout = p.out + (size_t)(smp ? 65536 : 0) * 1024 + (size_t)half * TG * 1024;
            const int S = smp ? 4096 : 2048, BG = TG / S;
            int gk = -1; const bf16_t* gA = nullptr; const bf16_t* gB = nullptr; bf16_t* gO = nullptr; int gN = 0, gK = 0, gact = 0;
            switch (s) {
                case 0: if (c == 0) { for (int i = threadIdx.x; i < 2048; i += 512) normw[i] = 0u; }
                        if (PM & 2) phase_row(nullptr, xin, nullptr, bufA, nullptr, p.in[2], TG, c, Gh); break;
                case 1: gk = 1; gA = bufA; gB = (const bf16_t*)(ws + WT_IN0); gO = bufBig; gN = 3072; gK = 1024; break;
                case 2: phase_norms(bufBig, normw, S, c, Gh); break;
                case 3: if (PM & 8) {
                    const int ln_ = threadIdx.x & 63;
                    const float s1 = wave_sum(p.in[8][ln_] * p.in[9][ln_]), s2 = wave_sum(p.in[10][ln_] * p.in[11][ln_]);
                    const float lam = expf(s1) - expf(s2) + 0.2f;
                    const int nQB = S / 128, nit = BG * 8 * nQB, NT = S / 64;
                    unsigned* qctr = barctr + 16 + half * 2 + g;
                    const unsigned* norms = normw;
                    LAS unsigned* itw = (LAS unsigned*)(lds + 67584);
                    for (;;) {
                        if (threadIdx.x == 0) *itw = __hip_atomic_fetch_add(qctr, 1u, __ATOMIC_RELAXED, __HIP_MEMORY_SCOPE_AGENT);
                        __syncthreads();
                        const int it = (int)*itw;
                        __syncthreads();
                        if (it >= nit) break;
                        const int hh = 7 - it / (BG * nQB), rem = it % (BG * nQB), b = rem / nQB, qb = rem % nQB;
                        const float msl = exp2f(-(float)(hh + 1)) * 1.4426950408889634f;
                        float W = 0.f;
#pragma unroll
                        for (int c = 0; c < 2; ++c) { const unsigned* n = norms + ((b * 8 + hh) * 2 + c) * 4;
                            const float q2 = __uint_as_float(__hip_atomic_load(n, __ATOMIC_RELAXED, __HIP_MEMORY_SCOPE_AGENT)), k2 = __uint_as_float(__hip_atomic_load(n + 1, __ATOMIC_RELAXED, __HIP_MEMORY_SCOPE_AGENT)),
                                        nz = __uint_as_float(__hip_atomic_load(n + 2, __ATOMIC_RELAXED, __HIP_MEMORY_SCOPE_AGENT));
                            W = fmaxf(W, (0.125f * 1.4426950408889634f * sqrtf(q2 * k2) * 1.001f + nz + 30.f) / msl); }
                        const int q0 = qb * 128;
                        const float lo_key = (float)q0 - W - 63.f, hi_key = (float)(q0 + 127) + W;
                        int tlo = lo_key <= 0.f ? 0 : (int)ceilf(lo_key * (1.f / 64.f)); int thi = hi_key >= (float)(S - 1) ? NT - 1 : (int)floorf(hi_key * (1.f / 64.f));
                        if (tlo > 2 * qb) tlo = 2 * qb; if (thi < 2 * qb + 1) thi = 2 * qb + 1;
                        if (((thi - tlo + 1) & 1) != 0) { if (thi < NT - 1) ++thi; else --tlo; }
                        const bf16_t* base = bufBig + (size_t)b * S * 3072;
                        da::attn_item(base + (size_t)q0 * 3072 + hh * 128, base + 1024 + hh * 128, base + 2048 + hh * 128,
                                      bufA + ((size_t)b * S + q0) * 1024 + hh * 128, q0, tlo, thi - tlo + 1, -msl, lam, p.in[12], lds);
                    }
                } break;
                case 4: gk = 1; gA = bufA; gB = (const bf16_t*)(ws + WT_OUT0); gO = bufY; gN = 1024; gK = 1024; break;
                case 5: if (PM & 2) phase_row(bufY, xin, xout, bufA, p.in[3], p.in[4], TG, c, Gh); break;
                case 6: gk = 1; gA = bufA; gB = (const bf16_t*)(ws + WT_W10); gO = bufBig; gN = 4096; gK = 1024; gact = 1; break;
                case 7: gk = 1; gA = bufBig; gB = (const bf16_t*)(ws + WT_W20); gO = bufA; gN = 1024; gK = 4096; break;
                case 8: if (PM & 2) phase_row(bufA, xout, xout, bufA, p.in[5], p.in[15], TG, c, Gh); break;
                case 9: gk = 1; gA = bufA; gB = (const bf16_t*)(ws + WT_IN1); gO = bufBig; gN = 4096; gK = 1024; break;
                case 10: if (PM & 16) {
                    const int nit = BG * 4 * 8;
                    for (int it = vid; it < nit; it += Gh) {
                        const int sl = it & 7, hh = (it >> 3) & 3, b = it >> 5;
                        const float lgf = log1pf(-expf(p.in[21][hh])) * 1.4426950408889634f, lgb = log1pf(-expf(p.in[22][hh])) * 1.4426950408889634f;
                        rt::ret_item(bufBig + (size_t)b * S * 4096, bufY + (size_t)b * S * 2048, S, hh, sl, lgf, lgb, lds);
                    }
                } break;
                case 11: gk = 1; gA = bufA; gB = (const bf16_t*)(ws + WT_IN1) + (size_t)4096 * 1024; gO = bufBig; gN = 2048; gK = 1024; break;
                case 12: if (PM & 32) phase_gn(bufY, bufBig, p.in[23], p.in[24], TG, c, Gh); break;
                case 13: gk = 1; gA = bufY; gB = (const bf16_t*)(ws + WT_OUT1); gO = bufA; gN = 1024; gK = 2048; break;
                case 14: if (PM & 2) phase_row(bufA, xout, xout, bufA, p.in[16], p.in[17], TG, c, Gh); break;
                case 15: gk = 1; gA = bufA; gB = (const bf16_t*)(ws + WT_W11); gO = bufBig; gN = 4096; gK = 1024; gact = 1; break;
                case 16: gk = 1; gA = bufBig; gB = (const bf16_t*)(ws + WT_W21); gO = bufA; gN = 1024; gK = 4096; break;
                case 17: if (PM & 2) phase_row(bufA, xout, xout, nullptr, p.in[18], nullptr, TG, c, Gh); break;
            }
            if ((PM & 4) && gk == 1) {
                pg8::Gemm gm; gm.A = gA; gm.Bt = gB; gm.M = TG; gm.N = gN; gm.K = gK;
                pg8::StaticOrder so; so.init(TG, gN, Gh, c);
                pg8::EpiBf16R ep; ep.O = gO; ep.ldc = gN; ep.act = gact;
                pg8::gemm_phase<pg8::EpiBf16R, pg8::StaticOrder>(lds, gm, so, ep);
            }
        }
        if (ph + 1 < p.ph_hi && ph + 1 < nph) {
            if (ph == 0) grid_barrier(barctr, (unsigned)G);
            else { ++nbar; grid_barrier(barctr + 32 + 16 * half, nbar * (unsigned)Gh); } }
    }
}

extern "C" void kernel_launch(void* const* d_in, const int* in_sizes, int n_in, void* d_out, int out_size, void* d_ws, size_t ws_size, hipStream_t stream) {
    static int grid_blocks = 0;
    if (grid_blocks == 0) {
        if (n_in != 27 || ws_size < WS_END) { fprintf(stderr, "kernel_launch: unexpected n_in %d / ws_size %zu (need %zu)\n", n_in, ws_size, (size_t)WS_END); grid_blocks = -1; return; }
        int dev = 0, cus = 0, per_cu = 0;
        hipGetDevice(&dev);
        hipDeviceGetAttribute(&cus, hipDeviceAttributeMultiprocessorCount, dev);
        if (hipFuncSetAttribute((const void*)mega, hipFuncAttributeMaxDynamicSharedMemorySize, LDS_BYTES) != hipSuccess) { fprintf(stderr, "kernel_launch: hipFuncSetAttribute failed\n"); grid_blocks = -1; return; }
        hipOccupancyMaxActiveBlocksPerMultiprocessor(&per_cu, (const void*)mega, 512, LDS_BYTES);
        if (per_cu < 1) { fprintf(stderr, "kernel_launch: occupancy query says %d blocks/CU\n", per_cu); per_cu = 1; }
        grid_blocks = cus * per_cu;
        grid_blocks &= ~15;
        fprintf(stderr, "kernel_launch: grid %d (cus %d x %d)\n", grid_blocks, cus, per_cu);
    }
    if (grid_blocks < 0) return;
    Params p{};
    for (int i = 0; i < 27; ++i) p.in[i] = (const float*)d_in[i];
    p.out = (float*)d_out; p.ws = (unsigned char*)d_ws; p.ph_lo = 0; p.ph_hi = 1 << 20;
    if (hipMemsetAsync((char*)d_ws + WS_BAR, 0, 256, stream) != hipSuccess) { fprintf(stderr, "kernel_launch: memset failed\n"); return; }
    void* args[] = {&p};
    hipError_t e = hipLaunchCooperativeKernel((const void*)mega, dim3(grid_blocks), dim3(512), args, LDS_BYTES, stream);
    if (e != hipSuccess) fprintf(stderr, "cooperative launch failed: %s (grid %d)\n", hipGetErrorString(e), grid_blocks);
}
```

```cpp
#include <hip/hip_runtime.h>
#include <hip/hip_cooperative_groups.h>
#include <cstdio>
namespace cg = cooperative_groups;

#define LAS __attribute__((address_space(3)))
#define DI __device__ __forceinline__
typedef unsigned short bf16_t;
typedef short bf16x8 __attribute__((ext_vector_type(8)));
typedef short s16x4 __attribute__((ext_vector_type(4)));
typedef float f32x4 __attribute__((ext_vector_type(4)));
typedef float f32x16 __attribute__((ext_vector_type(16)));
typedef unsigned u32x4 __attribute__((ext_vector_type(4)));
typedef unsigned u32x2 __attribute__((ext_vector_type(2)));

constexpr int TG = 65536;
constexpr int NGROUPS = 2;
constexpr int NPH = 18;
constexpr int LDS_BYTES = 153600;
constexpr float EPS = 1e-6f;
#ifndef PM
#define PM 63
#endif

constexpr size_t WT_IN0 = 0, WT_OUT0 = 6291456, WT_W10 = 8388608, WT_W20 = 16777216, WT_IN1 = 25165824, WT_OUT1 = 37748736,
                 WT_W11 = 41943040, WT_W21 = 50331648, BUF_A = 58720256, BUF_Y = 192937984, BUF_BIG = 461373440, WS_BAR = 998244352, WS_NORM = 998244352 + 256, WS_END = 998244352 + 256 + 8192;

struct Params {
    const float* in[27];
    float* out;
    unsigned char* ws;
    int ph_lo, ph_hi;
};

DI unsigned cvtpk(float lo, float hi) { unsigned r; asm volatile("v_cvt_pk_bf16_f32 %0, %1, %2" : "=v"(r) : "v"(lo), "v"(hi)); return r; }
DI float bf2f(unsigned short b) { return __uint_as_float(((unsigned)b) << 16); }
DI float bflo(unsigned w) { return __uint_as_float(w << 16); }
DI float bfhi(unsigned w) { return __uint_as_float(w & 0xffff0000u); }
DI float wave_sum(float v) {
#pragma unroll
    for (int o = 32; o; o >>= 1) v += __shfl_xor(v, o);
    return v;
}
DI int opaque_tid() { int t = threadIdx.x; asm volatile("" : "+v"(t)); return t; }
DI int crow(int r, int hi) { return (r & 3) + 8 * (r >> 2) + 4 * hi; }

namespace pg8 {
constexpr int BM = 256, BK = 64, HALF = 128, HTB = HALF * BK * 2, STAGE_BYTES = 8 * HTB, NXCD = 8, WGM = 8;
DI int lds_byte(int r, int c) { const int st = (r >> 4) * 2 + (c >> 5), rr = r & 15, cc = c & 31, ob = rr * 64 + cc * 2; return st * 1024 + (ob ^ (((ob >> 9) & 1) << 5)); }
DI void stage_rc(int b, int& R, int& C) { const int st = b / 1024, sb = b % 1024, swz = sb ^ (((sb >> 9) & 1) << 5); R = (st >> 1) * 16 + swz / 64; C = (st & 1) * 32 + (swz % 64) / 2; }
DI int perm32(int rho) { const int n = rho >> 4, i = rho & 15; return 8 * (i >> 2) + 4 * n + (i & 3); }
struct Unit { int pm, pn; };
struct Gemm { const bf16_t* A; const bf16_t* Bt; int M, N, K; };
struct StaticOrder {
    int nM, nN, nwg, G, c;
    DI void init(int M, int N, int G_, int c_) { nM = M / BM; nN = N / BM; nwg = nM * nN; G = G_; c = c_; }
    DI bool next(int i, Unit& u) const {
        const long L = (long)i * G + c; if (L >= nwg) return false;
        int wgid = (int)L; { const int q = nwg / NXCD, r = nwg % NXCD, xcd = wgid % NXCD, off = wgid / NXCD; wgid = (xcd < r ? xcd * (q + 1) : r * (q + 1) + (xcd - r) * q) + off; }
        const int nig = WGM * nN, gid = wgid / nig, fm = gid * WGM, gsz = (nM - fm) < WGM ? (nM - fm) : WGM;
        u.pm = fm + ((wgid % nig) % gsz); u.pn = (wgid % nig) / gsz; return true;
    }
};
struct EpiBf16R {
    static constexpr bool PERM = true;
    bf16_t* O; int ldc; int act;
    DI void operator()(const f32x4 (&acc)[2][2][4][2], const Unit& u, int wr, int wc, int fr, int fq) const {
        const int row0 = u.pm * BM + wr * 64 + fr; const int col0 = u.pn * BM + wc * 32 + 8 * fq;
#pragma unroll
        for (int ai = 0; ai < 2; ++ai)
#pragma unroll
            for (int m = 0; m < 4; ++m) { bf16_t* rowp = O + (size_t)(row0 + ai * HALF + m * 16) * ldc + col0;
#pragma unroll
                for (int bj = 0; bj < 2; ++bj) { f32x4 v0 = acc[ai][bj][m][0], v1 = acc[ai][bj][m][1];
                    if (act) {
#pragma unroll
                        for (int j = 0; j < 4; ++j) { float a = fmaxf(v0[j], 0.f), b = fmaxf(v1[j], 0.f); v0[j] = a * a; v1[j] = b * b; } }
                    u32x4 w; w.x = cvtpk(v0[0], v0[1]); w.y = cvtpk(v0[2], v0[3]); w.z = cvtpk(v1[0], v1[1]); w.w = cvtpk(v1[2], v1[3]);
                    *(u32x4*)(rowp + bj * HALF) = w; } }
    }
};

template <class Epi, class Sched>
DI void gemm_phase(LAS unsigned char* lds, const Gemm g, const Sched& S, const Epi& E) {
    const int tid = opaque_tid(), wid = __builtin_amdgcn_readfirstlane(tid >> 6), lane = tid & 63, wr = wid >> 2, wc = wid & 3, fr = lane & 15, fq = lane >> 4;
    const int K = g.K, nt = K / BK;
    unsigned voffA[2], voffB[2];
#pragma unroll
    for (int i = 0; i < 2; ++i) { int R, C; stage_rc(tid * 16 + i * 8192, R, C); const int Rb = Epi::PERM ? ((R & ~31) + perm32(R & 31)) : R;
        voffA[i] = (unsigned)(R * K + C) * 2u; voffB[i] = (unsigned)(Rb * K + C) * 2u; }
    const size_t kstep = (size_t)(BK * 2);
    const size_t hstep = (size_t)HALF * K * 2;
    const size_t tstep = 2 * hstep;
    const unsigned ldsw = (unsigned)wid * 1024u;
    const int aoff = lds_byte(wr * 64 + fr, fq * 8), boff = lds_byte(wc * 32 + fr, fq * 8);
#define PG8_SA(b, h) (((b) * 2 + (h)) * HTB)
#define PG8_SB(b, h) ((4 + (b) * 2 + (h)) * HTB)
#define PG8_STAGE(bufoff, gbase, voff) do { _Pragma("unroll") for (int _i = 0; _i < 2; ++_i) \
        __builtin_amdgcn_global_load_lds((const unsigned*)((const char*)(gbase) + (voff)[_i]), (LAS unsigned*)(lds + (bufoff) + ldsw + _i * 8192), 16, 0, 0); } while (0)
#define PG8_LDA(dst, b, h) do { _Pragma("unroll") for (int m = 0; m < 4; ++m) _Pragma("unroll") for (int k = 0; k < 2; ++k) dst[m][k] = *(const LAS bf16x8*)(lds + PG8_SA(b, h) + aoff + m * 2048 + k * 1024); } while (0)
#define PG8_LDB(dst, b, h) do { _Pragma("unroll") for (int n = 0; n < 2; ++n) _Pragma("unroll") for (int k = 0; k < 2; ++k) dst[n][k] = *(const LAS bf16x8*)(lds + PG8_SB(b, h) + boff + n * 2048 + k * 1024); } while (0)
#define PG8_MMA(ai, bj, At, Bt) do { __builtin_amdgcn_s_setprio(1); _Pragma("unroll") for (int m = 0; m < 4; ++m) _Pragma("unroll") for (int n = 0; n < 2; ++n) _Pragma("unroll") for (int k = 0; k < 2; ++k) \
        acc[ai][bj][m][n] = __builtin_amdgcn_mfma_f32_16x16x32_bf16(Bt[n][k], At[m][k], acc[ai][bj][m][n], 0, 0, 0); __builtin_amdgcn_s_setprio(0); } while (0)
#define PG8_WAIT_V(n) asm volatile("s_waitcnt vmcnt(" #n ")" ::: "memory")
#define PG8_WAIT_L(n) asm volatile("s_waitcnt lgkmcnt(" #n ")" ::: "memory")
#define PG8_BAR __builtin_amdgcn_s_barrier()
#define PG8_SCHED __builtin_amdgcn_sched_barrier(0)
    Unit cur, nxt; int ui = 0;
    if (!S.next(0, cur)) return;
    f32x4 acc[2][2][4][2];
#pragma unroll
    for (int a = 0; a < 2; ++a)
#pragma unroll
        for (int b = 0; b < 2; ++b)
#pragma unroll
            for (int m = 0; m < 4; ++m)
#pragma unroll
                for (int n = 0; n < 2; ++n) acc[a][b][m][n] = (f32x4){0.f, 0.f, 0.f, 0.f};
    bf16x8 At[4][2], B0[2][2], B1[2][2];
    const char* cA = (const char*)g.A + (size_t)cur.pm * tstep; const char* cB = (const char*)g.Bt + (size_t)cur.pn * tstep;
    PG8_STAGE(PG8_SB(0, 0), cB, voffB); PG8_STAGE(PG8_SA(0, 0), cA, voffA); PG8_STAGE(PG8_SB(0, 1), cB + hstep, voffB); PG8_STAGE(PG8_SA(0, 1), cA + hstep, voffA);
    if (wr == 1) PG8_BAR;
    PG8_WAIT_V(4); PG8_BAR;
    PG8_STAGE(PG8_SB(1, 0), cB + kstep, voffB); PG8_STAGE(PG8_SA(1, 0), cA + kstep, voffA); PG8_STAGE(PG8_SB(1, 1), cB + hstep + kstep, voffB);
    PG8_WAIT_V(6); PG8_BAR;
    for (;;) {
        const bool has_next = S.next(ui + 1, nxt);
        const char* nA = has_next ? (const char*)g.A + (size_t)nxt.pm * tstep : cA; const char* nB = has_next ? (const char*)g.Bt + (size_t)nxt.pn * tstep : cB;
        for (int t = 0; t < nt; t += 2) {
            const bool last = (t == nt - 2);
            const char* a1 = cA + (size_t)(t + 1) * kstep;
            const char* a2 = last ? nA : cA + (size_t)(t + 2) * kstep; const char* b2 = last ? nB : cB + (size_t)(t + 2) * kstep;
            const char* a3 = a2 + kstep; const char* b3 = b2 + kstep;
            PG8_LDB(B0, 0, 0); PG8_SCHED; PG8_LDA(At, 0, 0); PG8_STAGE(PG8_SA(1, 1), a1 + hstep, voffA);
            PG8_WAIT_L(8); PG8_BAR; PG8_WAIT_L(0); PG8_MMA(0, 0, At, B0); PG8_BAR; PG8_SCHED;
            PG8_LDB(B1, 0, 1); PG8_STAGE(PG8_SB(0, 0), b2, voffB);
            PG8_BAR; PG8_WAIT_L(0); PG8_MMA(0, 1, At, B1); PG8_BAR;
            PG8_LDA(At, 0, 1); PG8_STAGE(PG8_SA(0, 0), a2, voffA);
            PG8_BAR; PG8_WAIT_L(0); PG8_MMA(1, 0, At, B0); PG8_BAR; PG8_SCHED;
            PG8_STAGE(PG8_SB(0, 1), b2 + hstep, voffB);
            PG8_WAIT_V(6); PG8_BAR; PG8_MMA(1, 1, At, B1); PG8_BAR;
            PG8_LDB(B0, 1, 0); PG8_SCHED; PG8_LDA(At, 1, 0); PG8_STAGE(PG8_SA(0, 1), a2 + hstep, voffA);
            PG8_WAIT_L(8); PG8_BAR; PG8_WAIT_L(0); PG8_MMA(0, 0, At, B0); PG8_BAR; PG8_SCHED;
            PG8_LDB(B1, 1, 1); PG8_STAGE(PG8_SB(1, 0), b3, voffB);
            PG8_BAR; PG8_WAIT_L(0); PG8_MMA(0, 1, At, B1); PG8_BAR;
            PG8_LDA(At, 1, 1); PG8_STAGE(PG8_SA(1, 0), a3, voffA);
            PG8_BAR; PG8_WAIT_L(0); PG8_MMA(1, 0, At, B0); PG8_BAR; PG8_SCHED;
            PG8_STAGE(PG8_SB(1, 1), b3 + hstep, voffB);
            PG8_WAIT_V(6); PG8_BAR; PG8_MMA(1, 1, At, B1); PG8_BAR;
        }
        E(acc, cur, wr, wc, fr, fq);
        if (!has_next) break;
#pragma unroll
        for (int a = 0; a < 2; ++a)
#pragma unroll
            for (int b = 0; b < 2; ++b)
#pragma unroll
                for (int m = 0; m < 4; ++m)
#pragma unroll
                    for (int n = 0; n < 2; ++n) acc[a][b][m][n] = (f32x4){0.f, 0.f, 0.f, 0.f};
        cur = nxt; cA = nA; cB = nB; ++ui;
    }
    PG8_WAIT_V(0);
    if (wr == 0) PG8_BAR;
    PG8_BAR;
#undef PG8_SA
#undef PG8_SB
#undef PG8_STAGE
#undef PG8_LDA
#undef PG8_LDB
#undef PG8_MMA
#undef PG8_WAIT_V
#undef PG8_WAIT_L
#undef PG8_BAR
#undef PG8_SCHED
}
}

DI void wt_tiles(const float* __restrict__ W, bf16_t* __restrict__ Wt, int K, int N, LAS unsigned char* lds, int& tile_base) {
    LAS float* t = (LAS float*)lds;
    const int nk = K / 64, nn = N / 64, ntl = nk * nn, tid = opaque_tid();
    for (int tl = ((int)blockIdx.x - tile_base % (int)gridDim.x + (int)gridDim.x) % (int)gridDim.x; tl < ntl; tl += gridDim.x) {
        const int tk = tl / nn, tn = tl % nn;
        { const int kk = tid >> 3, c8 = (tid & 7) * 8; const float* src = W + (size_t)(tk * 64 + kk) * N + tn * 64 + c8;
          const f32x4 a = *(const f32x4*)src, b = *(const f32x4*)(src + 4);
          LAS float* d = t + kk * 65 + c8; d[0] = a[0]; d[1] = a[1]; d[2] = a[2]; d[3] = a[3]; d[4] = b[0]; d[5] = b[1]; d[6] = b[2]; d[7] = b[3]; }
        __syncthreads();
        { const int n = tid >> 3, k8 = (tid & 7) * 8; float v[8];
#pragma unroll
          for (int j = 0; j < 8; ++j) v[j] = t[(k8 + j) * 65 + n];
          u32x4 w; w.x = cvtpk(v[0], v[1]); w.y = cvtpk(v[2], v[3]); w.z = cvtpk(v[4], v[5]); w.w = cvtpk(v[6], v[7]);
          *(u32x4*)(Wt + (size_t)(tn * 64 + n) * K + tk * 64 + k8) = w; }
        __syncthreads();
    }
    tile_base += ntl;
}

DI void phase_row(const bf16_t* m, const float* xsrc, float* xdst, bf16_t* hn, const float* gpost, const float* gnext, int rows) {
    const int tid_ = opaque_tid(); const int lane = tid_ & 63, wid = tid_ >> 6;
    const int nw = gridDim.x * 8;
    for (int row0 = blockIdx.x * 8 + wid; row0 < rows; row0 += 2 * nw) {
        const int rws[2] = {row0, row0 + nw < rows ? row0 + nw : row0};
        float x[2][16]; u32x4 mw[2][2];
#pragma unroll
        for (int q = 0; q < 2; ++q)
#pragma unroll
            for (int c = 0; c < 2; ++c) { const float* s = xsrc + (size_t)rws[q] * 1024 + c * 512 + lane * 8; const f32x4 a = *(const f32x4*)s, b = *(const f32x4*)(s + 4);
#pragma unroll
                for (int j = 0; j < 4; ++j) { x[q][c * 8 + j] = a[j]; x[q][c * 8 + 4 + j] = b[j]; } }
        if (m) {
#pragma unroll
            for (int q = 0; q < 2; ++q)
#pragma unroll
                for (int c = 0; c < 2; ++c) mw[q][c] = *(const u32x4*)(m + (size_t)rws[q] * 1024 + c * 512 + lane * 8);
            f32x4 ga[2], gb[2];
#pragma unroll
            for (int c = 0; c < 2; ++c) { const float* gp = gpost + c * 512 + lane * 8; ga[c] = *(const f32x4*)gp; gb[c] = *(const f32x4*)(gp + 4); }
#pragma unroll
            for (int q = 0; q < 2; ++q) {
                float mv[16]; float ss = 0.f;
#pragma unroll
                for (int c = 0; c < 2; ++c)
#pragma unroll
                    for (int j = 0; j < 4; ++j) { mv[c * 8 + 2 * j] = bflo(mw[q][c][j]); mv[c * 8 + 2 * j + 1] = bfhi(mw[q][c][j]); }
#pragma unroll
                for (int j = 0; j < 16; ++j) ss += mv[j] * mv[j];
                ss = wave_sum(ss);
                const float r = rsqrtf(ss * (1.f / 1024.f) + EPS);
#pragma unroll
                for (int c = 0; c < 2; ++c)
#pragma unroll
                    for (int j = 0; j < 4; ++j) { x[q][c * 8 + j] += mv[c * 8 + j] * r * ga[c][j]; x[q][c * 8 + 4 + j] += mv[c * 8 + 4 + j] * r * gb[c][j]; }
            }
        }
        if (xdst) {
#pragma unroll
            for (int q = 0; q < 2; ++q)
#pragma unroll
                for (int c = 0; c < 2; ++c) { float* d = xdst + (size_t)rws[q] * 1024 + c * 512 + lane * 8;
                    *(f32x4*)d = (f32x4){x[q][c * 8], x[q][c * 8 + 1], x[q][c * 8 + 2], x[q][c * 8 + 3]}; *(f32x4*)(d + 4) = (f32x4){x[q][c * 8 + 4], x[q][c * 8 + 5], x[q][c * 8 + 6], x[q][c * 8 + 7]}; }
        }
        if (hn) {
            f32x4 ga[2], gb[2];
#pragma unroll
            for (int c = 0; c < 2; ++c) { const float* gp = gnext + c * 512 + lane * 8; ga[c] = *(const f32x4*)gp; gb[c] = *(const f32x4*)(gp + 4); }
#pragma unroll
            for (int q = 0; q < 2; ++q) {
                float ss = 0.f;
#pragma unroll
                for (int j = 0; j < 16; ++j) ss += x[q][j] * x[q][j];
                ss = wave_sum(ss);
                const float r = rsqrtf(ss * (1.f / 1024.f) + EPS);
#pragma unroll
                for (int c = 0; c < 2; ++c) {
                    u32x4 w; w.x = cvtpk(x[q][c * 8] * r * ga[c][0], x[q][c * 8 + 1] * r * ga[c][1]); w.y = cvtpk(x[q][c * 8 + 2] * r * ga[c][2], x[q][c * 8 + 3] * r * ga[c][3]);
                    w.z = cvtpk(x[q][c * 8 + 4] * r * gb[c][0], x[q][c * 8 + 5] * r * gb[c][1]); w.w = cvtpk(x[q][c * 8 + 6] * r * gb[c][2], x[q][c * 8 + 7] * r * gb[c][3]);
                    *(u32x4*)(hn + (size_t)rws[q] * 1024 + c * 512 + lane * 8) = w; }
            }
        }
    }
}

DI void phase_gn(bf16_t* y, const bf16_t* big, const float* gw, const float* gb, int rows) {
    const int tid_ = opaque_tid(); const int lane = tid_ & 63, wid = tid_ >> 6;
    for (int row = blockIdx.x * 8 + wid; row < rows; row += gridDim.x * 8) {
        u32x4 yw[4], gq[4];
#pragma unroll
        for (int hh = 0; hh < 4; ++hh) { yw[hh] = *(const u32x4*)(y + (size_t)row * 2048 + hh * 512 + lane * 8); gq[hh] = *(const u32x4*)(big + (size_t)row * 2048 + hh * 512 + lane * 8); }
#pragma unroll
        for (int hh = 0; hh < 4; ++hh) {
            bf16_t* yp = y + (size_t)row * 2048 + hh * 512 + lane * 8;
            float v[8], g[8];
#pragma unroll
            for (int j = 0; j < 4; ++j) { v[2 * j] = bflo(yw[hh][j]); v[2 * j + 1] = bfhi(yw[hh][j]); g[2 * j] = bflo(gq[hh][j]); g[2 * j + 1] = bfhi(gq[hh][j]); }
            float s = 0.f;
#pragma unroll
            for (int j = 0; j < 8; ++j) s += v[j];
            const float mu = wave_sum(s) * (1.f / 512.f);
            float q = 0.f;
#pragma unroll
            for (int j = 0; j < 8; ++j) { v[j] -= mu; q += v[j] * v[j]; }
            const float rs = rsqrtf(wave_sum(q) * (1.f / 512.f) + EPS);
            const float* wp = gw + hh * 512 + lane * 8; const float* bp = gb + hh * 512 + lane * 8;
            const f32x4 w0 = *(const f32x4*)wp, w1 = *(const f32x4*)(wp + 4), b0 = *(const f32x4*)bp, b1 = *(const f32x4*)(bp + 4);
            float o[8];
#pragma unroll
            for (int j = 0; j < 8; ++j) { const float wj = j < 4 ? w0[j & 3] : w1[j & 3], bj = j < 4 ? b0[j & 3] : b1[j & 3];
                const float sg = g[j] / (1.f + __expf(-g[j])); o[j] = sg * (v[j] * rs * wj + bj); }
            u32x4 ow; ow.x = cvtpk(o[0], o[1]); ow.y = cvtpk(o[2], o[3]); ow.z = cvtpk(o[4], o[5]); ow.w = cvtpk(o[6], o[7]);
            *(u32x4*)yp = ow;
        }
    }
}

DI void phase_norms(const bf16_t* __restrict__ qkv, unsigned* norms, int S) {
    const int tid = opaque_tid(), lane = tid & 63, wid = tid >> 6;
    for (int chunk = blockIdx.x * 8 + wid; chunk < TG / 32; chunk += gridDim.x * 8) {
        const int t0 = chunk * 32, b = t0 / S;
        float q2 = 0.f, k2 = 0.f, nz = 0.f;
#pragma unroll 2
        for (int t = 0; t < 32; ++t) {
            const bf16_t* row = qkv + (size_t)(t0 + t) * 3072 + lane * 16;
            const u32x4 qa = *(const u32x4*)row, qb = *(const u32x4*)(row + 8), ka = *(const u32x4*)(row + 1024), kb = *(const u32x4*)(row + 1032);
            float sq = 0.f, sk = 0.f, sd = 0.f;
#pragma unroll
            for (int j = 0; j < 4; ++j) {
                { const float a = bflo(qa[j]), c = bfhi(qa[j]), d = bflo(ka[j]), e = bfhi(ka[j]); sq += a * a + c * c; sk += d * d + e * e; sd += a * d + c * e; }
                { const float a = bflo(qb[j]), c = bfhi(qb[j]), d = bflo(kb[j]), e = bfhi(kb[j]); sq += a * a + c * c; sk += d * d + e * e; sd += a * d + c * e; } }
            sq += __shfl_xor(sq, 1); sk += __shfl_xor(sk, 1); sd += __shfl_xor(sd, 1);
            sq += __shfl_xor(sq, 2); sk += __shfl_xor(sk, 2); sd += __shfl_xor(sd, 2);
            q2 = fmaxf(q2, sq); k2 = fmaxf(k2, sk); nz = fmaxf(nz, -sd * (0.125f * 1.4426950408889634f));
        }
        if ((lane & 3) == 0) { unsigned* n = norms + ((b * 8 + (lane >> 3)) * 2 + ((lane & 7) >> 2)) * 4;
            atomicMax(n, __float_as_uint(q2)); atomicMax(n + 1, __float_as_uint(k2)); atomicMax(n + 2, __float_as_uint(nz)); }
    }
}

namespace da {
constexpr int SHM_V = 64 * 128 * 2, SHM_K = 64 * 128 * 2, LDQ = 3072, LDK = 3072;
constexpr float C = 0.125f * 1.4426950408889634f;
constexpr float THRZ = 8.f * 1.4426950408889634f;
#define KSWZ(row, colB) ((row) * 256 + ((colB) ^ (((row) & 7) << 4)))
#define SBAR() __builtin_amdgcn_sched_barrier(0)

DI void partialSM(f32x16& p0, f32x16& p1, float& m_reg, float& mn, float& alpha, float tb, float nsl) {
#pragma unroll
    for (int r = 0; r < 16; ++r) { const float t0 = tb + (float)((r & 3) + 8 * (r >> 2)); const float t1 = t0 + 32.f;
        p0[r] = fmaf(p0[r], C, nsl * fabsf(t0)); p1[r] = fmaf(p1[r], C, nsl * fabsf(t1)); }
    float pmax = p0[0];
#pragma unroll
    for (int r = 1; r < 16; ++r) pmax = fmaxf(pmax, p0[r]);
#pragma unroll
    for (int r = 0; r < 16; ++r) pmax = fmaxf(pmax, p1[r]);
    { auto rr = __builtin_amdgcn_permlane32_swap(__float_as_uint(pmax), __float_as_uint(pmax), false, false);
      pmax = fmaxf(__uint_as_float(rr[0]), __uint_as_float(rr[1])); }
    if (__builtin_expect(__all(pmax - m_reg <= THRZ), 1)) { mn = m_reg; alpha = 1.f; }
    else { mn = fmaxf(m_reg, pmax); alpha = __builtin_amdgcn_exp2f(m_reg - mn); m_reg = mn; }
#pragma unroll
    for (int r = 0; r < 16; ++r) { p0[r] -= mn; p1[r] -= mn; }
#pragma unroll
    for (int r = 0; r < 16; ++r) p0[r] = __builtin_amdgcn_exp2f(p0[r]);
}
DI void partialSM_lin(f32x16& p0, f32x16& p1, float& m_reg, float& mn, float& alpha, float tb, float sgn_nsl) {
    asm volatile("" : "+v"(sgn_nsl));
#pragma unroll
    for (int r = 0; r < 16; ++r) { const float k = sgn_nsl * (float)((r & 3) + 8 * (r >> 2)); p0[r] = fmaf(p0[r], C, k); p1[r] = fmaf(p1[r], C, k); }
    float mx0 = p0[0], mx1 = p1[0];
#pragma unroll
    for (int r = 1; r < 16; ++r) { mx0 = fmaxf(mx0, p0[r]); mx1 = fmaxf(mx1, p1[r]); }
    const float base0 = sgn_nsl * tb, base1 = base0 + 32.f * sgn_nsl;
    float pmax = fmaxf(mx0 + base0, mx1 + base1);
    { auto rr = __builtin_amdgcn_permlane32_swap(__float_as_uint(pmax), __float_as_uint(pmax), false, false);
      pmax = fmaxf(__uint_as_float(rr[0]), __uint_as_float(rr[1])); }
    if (__builtin_expect(__all(pmax - m_reg <= THRZ), 1)) { mn = m_reg; alpha = 1.f; }
    else { mn = fmaxf(m_reg, pmax); alpha = __builtin_amdgcn_exp2f(m_reg - mn); m_reg = mn; }
    const float d0 = mn - base0, d1 = mn - base1;
#pragma unroll
    for (int r = 0; r < 16; ++r) { p0[r] -= d0; p1[r] -= d1; }
#pragma unroll
    for (int r = 0; r < 16; ++r) p0[r] = __builtin_amdgcn_exp2f(p0[r]);
}
DI void finishSM(f32x16& p0, f32x16& p1, float alpha, float& l_reg, bf16x8& pa0, bf16x8& pa1, bf16x8& pa2, bf16x8& pa3) {
#pragma unroll
    for (int r = 0; r < 16; ++r) p1[r] = __builtin_amdgcn_exp2f(p1[r]);
    float ps = 0;
#pragma unroll
    for (int r = 0; r < 16; ++r) ps += p0[r];
#pragma unroll
    for (int r = 0; r < 16; ++r) ps += p1[r];
    { auto rr = __builtin_amdgcn_permlane32_swap(__float_as_uint(ps), __float_as_uint(ps), false, false);
      ps = __uint_as_float(rr[0]) + __uint_as_float(rr[1]); }
    l_reg = l_reg * alpha + ps;
#define PK4(P, BASE, OUT) do { unsigned a0 = cvtpk(P[BASE + 0], P[BASE + 1]), a1 = cvtpk(P[BASE + 2], P[BASE + 3]);   \
    unsigned b0 = cvtpk(P[BASE + 4], P[BASE + 5]), b1 = cvtpk(P[BASE + 6], P[BASE + 7]);                              \
    auto r0 = __builtin_amdgcn_permlane32_swap(a0, b0, false, false); auto r1 = __builtin_amdgcn_permlane32_swap(a1, b1, false, false); \
    u32x4 w = {r0[0], r1[0], r0[1], r1[1]}; OUT = __builtin_bit_cast(bf16x8, w); } while (0)
    PK4(p0, 0, pa0); PK4(p0, 8, pa1); PK4(p1, 0, pa2); PK4(p1, 8, pa3);
#undef PK4
}
DI void qkt(f32x16& p0, f32x16& p1, const LAS unsigned char* Ks, const bf16x8* qr, int r32, int hi, int cmap) {
#pragma unroll
    for (int r = 0; r < 16; ++r) { p0[r] = 0.f; p1[r] = 0.f; }
#pragma unroll
    for (int d0 = 0; d0 < 4; ++d0) { const int cb = (cmap * 64 + d0 * 16 + hi * 8) * 2;
        const bf16x8 b0 = *(const LAS bf16x8*)(Ks + KSWZ(r32, cb));
        const bf16x8 b1 = *(const LAS bf16x8*)(Ks + KSWZ(32 + r32, cb));
        p0 = __builtin_amdgcn_mfma_f32_32x32x16_bf16(b0, qr[d0], p0, 0, 0, 0);
        p1 = __builtin_amdgcn_mfma_f32_32x32x16_bf16(b1, qr[d0], p1, 0, 0, 0); }
}
DI int v_st(int k, int c) { const int kk = (k & ~0xC) | ((k & 4) << 1) | ((k & 8) >> 1); return ((kk >> 3) * 4 + (c >> 5)) * 512 + ((kk & 7) * 32 + (c & 31)) * 2; }
DI int v_rd_base(int lane) { return ((lane & 3) << 3) | (((lane >> 2) & 3) << 6) | (((lane >> 4) & 1) << 5) | (((lane >> 5) & 1) << 8); }
constexpr int v_rd_off(int d0, int ks, int half) { return d0 * 512 + ks * 4096 + half * 2048; }
template <int OFF> DI s16x4 tr_read(int vb) { s16x4 r; asm volatile("ds_read_b64_tr_b16 %0, %1 offset:%2" : "=&v"(r) : "v"(vb), "i"(OFF) : "memory"); return r; }
template <int D0> DI void pv_one(f32x16& od, int vb, bf16x8 pa0, bf16x8 pa1, bf16x8 pa2, bf16x8 pa3) {
    const s16x4 l0 = tr_read<v_rd_off(D0, 0, 0)>(vb), h0 = tr_read<v_rd_off(D0, 0, 1)>(vb), l1 = tr_read<v_rd_off(D0, 1, 0)>(vb), h1 = tr_read<v_rd_off(D0, 1, 1)>(vb);
    const s16x4 l2 = tr_read<v_rd_off(D0, 2, 0)>(vb), h2 = tr_read<v_rd_off(D0, 2, 1)>(vb), l3 = tr_read<v_rd_off(D0, 3, 0)>(vb), h3 = tr_read<v_rd_off(D0, 3, 1)>(vb);
    asm volatile("s_waitcnt lgkmcnt(0)" ::: "memory"); SBAR();
#define PK(L, H) (bf16x8){L[0], L[1], L[2], L[3], H[0], H[1], H[2], H[3]}
    od = __builtin_amdgcn_mfma_f32_32x32x16_bf16(pa0, PK(l0, h0), od, 0, 0, 0);
    od = __builtin_amdgcn_mfma_f32_32x32x16_bf16(pa1, PK(l1, h1), od, 0, 0, 0);
    od = __builtin_amdgcn_mfma_f32_32x32x16_bf16(pa2, PK(l2, h2), od, 0, 0, 0);
    od = __builtin_amdgcn_mfma_f32_32x32x16_bf16(pa3, PK(l3, h3), od, 0, 0, 0);
#undef PK
}
DI void pv_d0(f32x16* o, int vb, bf16x8 pa0, bf16x8 pa1, bf16x8 pa2, bf16x8 pa3) {
    pv_one<0>(o[0], vb, pa0, pa1, pa2, pa3); pv_one<1>(o[1], vb, pa0, pa1, pa2, pa3); pv_one<2>(o[2], vb, pa0, pa1, pa2, pa3); pv_one<3>(o[3], vb, pa0, pa1, pa2, pa3);
}

DI void attn_item(const bf16_t* __restrict__ Qb, const bf16_t* __restrict__ Kh, const bf16_t* __restrict__ Vh, bf16_t* __restrict__ Ob,
                  int q0, int tile0, int ntiles, float nsl, float lam, const float* __restrict__ gsub, LAS unsigned char* lds) {
    const int tid = opaque_tid(), wid = tid >> 6, lane = tid & 63, r32 = lane & 31, hi = lane >> 5;
    const int pair = wid >> 1, cmap = wid & 1;
    Kh += (long)tile0 * 64 * LDK; Vh += (long)tile0 * 64 * LDK;
    LAS unsigned char* V_lds = lds; LAS unsigned char* K_lds = lds + 2 * SHM_V;
    LAS float* wsf = (LAS float*)(lds + 2 * SHM_V + 2 * SHM_K) + wid * 64; LAS float* li_l = wsf; LAS float* al_l = wsf + 32;
    float m_reg = -1e30f, l_reg = 0.f; f32x16 o[4]; bf16x8 qr[4];
#pragma unroll
    for (int d = 0; d < 4; ++d)
#pragma unroll
        for (int r = 0; r < 16; ++r) o[d][r] = 0.f;
    const bf16_t* Qw = Qb + (long)(pair * 32 + r32) * LDQ + cmap * 64 + hi * 8;
#pragma unroll
    for (int d0 = 0; d0 < 4; ++d0) qr[d0] = *(const bf16x8*)(Qw + d0 * 16);
    const float tq = 4.f * (float)hi - (float)(q0 + pair * 32 + r32) + (float)(tile0 * 64);
    const int sr = tid >> 4, sc = (tid & 15) * 8, vst0 = v_st(sr, sc), vst1 = v_st(32 + sr, sc);
    const int vb0 = (int)(unsigned)(size_t)V_lds + v_rd_base(lane);
    bf16x8 vs0, vs1, ks0, ks1;
#define SLOAD(k0) do { vs0 = *(const bf16x8*)(&Vh[(long)((k0) + sr) * LDK + sc]); vs1 = *(const bf16x8*)(&Vh[(long)((k0) + 32 + sr) * LDK + sc]); \
    ks0 = *(const bf16x8*)(&Kh[(long)((k0) + sr) * LDK + sc]); ks1 = *(const bf16x8*)(&Kh[(long)((k0) + 32 + sr) * LDK + sc]); } while (0)
#define SWRITE(b) do { *(LAS bf16x8*)(V_lds + (b) * SHM_V + vst0) = vs0; *(LAS bf16x8*)(V_lds + (b) * SHM_V + vst1) = vs1; const int kc = sc * 2; \
    *(LAS bf16x8*)(K_lds + (b) * SHM_K + KSWZ(sr, kc)) = ks0; *(LAS bf16x8*)(K_lds + (b) * SHM_K + KSWZ(32 + sr, kc)) = ks1; } while (0)
#define RESC(a) do { if (__any((a) < 1.f)) { if (hi == 0) al_l[r32] = (a); asm volatile("s_waitcnt lgkmcnt(0)" ::: "memory"); \
    _Pragma("unroll") for (int d = 0; d < 4; ++d) _Pragma("unroll") for (int r = 0; r < 16; ++r) o[d][r] *= al_l[crow(r, hi)]; } } while (0)
    f32x16 pA0, pA1, pB0, pB1; float mnA, mnB, alA, alB; bf16x8 pa0, pa1, pa2, pa3; const int NT = ntiles;
    const int dlo = (q0 >> 6) - tile0;
#define PSM(P0, P1, MN, AL, JR) do { const int jr_ = (JR); const float tb_ = tq + (float)(jr_ * 64); \
        if (jr_ < dlo || jr_ > dlo + 1) partialSM_lin(P0, P1, m_reg, MN, AL, tb_, jr_ < dlo ? -nsl : nsl); \
        else partialSM(P0, P1, m_reg, MN, AL, tb_, nsl); } while (0)
    SLOAD(0); SWRITE(0); __syncthreads();
    qkt(pA0, pA1, K_lds, qr, r32, hi, cmap); PSM(pA0, pA1, mnA, alA, 0);
    SLOAD(64); SWRITE(1); __syncthreads();
    for (int j = 1; j + 1 < NT; j += 2) {
        SBAR(); qkt(pB0, pB1, K_lds + SHM_K, qr, r32, hi, cmap);
        finishSM(pA0, pA1, alA, l_reg, pa0, pa1, pa2, pa3); SBAR();
        SLOAD((j + 1) * 64); SBAR();
        pv_d0(o, vb0, pa0, pa1, pa2, pa3); PSM(pB0, pB1, mnB, alB, j);
        __syncthreads(); SWRITE(0);
        RESC(alB); __syncthreads();
        SBAR(); qkt(pA0, pA1, K_lds, qr, r32, hi, cmap);
        finishSM(pB0, pB1, alB, l_reg, pa0, pa1, pa2, pa3); SBAR();
        SLOAD((j + 2) * 64); SBAR();
        pv_d0(o, vb0 + SHM_V, pa0, pa1, pa2, pa3); PSM(pA0, pA1, mnA, alA, j + 1);
        __syncthreads(); SWRITE(1);
        RESC(alA); __syncthreads();
    }
    SBAR(); qkt(pB0, pB1, K_lds + SHM_K, qr, r32, hi, cmap);
    finishSM(pA0, pA1, alA, l_reg, pa0, pa1, pa2, pa3); SBAR();
    pv_d0(o, vb0, pa0, pa1, pa2, pa3); PSM(pB0, pB1, mnB, alB, NT - 1);
    __syncthreads(); RESC(alB);
    finishSM(pB0, pB1, alB, l_reg, pa0, pa1, pa2, pa3); SBAR();
    pv_d0(o, vb0 + SHM_V, pa0, pa1, pa2, pa3);
    if (hi == 0) li_l[r32] = l_reg; asm volatile("s_waitcnt lgkmcnt(0)" ::: "memory");
    float rli[16];
    const float msc = cmap ? -lam : 1.f;
#pragma unroll
    for (int r = 0; r < 16; ++r) rli[r] = __builtin_amdgcn_rcpf(li_l[crow(r, hi)]) * msc;
    __syncthreads();
    LAS float* Obuf = (LAS float*)lds;
    if (cmap == 1) {
#pragma unroll
        for (int d0 = 0; d0 < 4; ++d0)
#pragma unroll
            for (int r = 0; r < 16; ++r) Obuf[(pair * 32 + crow(r, hi)) * 128 + d0 * 32 + r32] = o[d0][r] * rli[r];
    }
    __syncthreads();
    if (cmap == 0) {
#pragma unroll
        for (int d0 = 0; d0 < 4; ++d0)
#pragma unroll
            for (int r = 0; r < 16; ++r) Obuf[(pair * 32 + crow(r, hi)) * 128 + d0 * 32 + r32] += o[d0][r] * rli[r];
    }
    __syncthreads();
    { const int row = tid >> 2, qt = tid & 3; const LAS float* src = Obuf + row * 128 + qt * 32; float v[32]; float ss = 0.f;
#pragma unroll
      for (int j = 0; j < 8; ++j) { const f32x4 t = *(const LAS f32x4*)(src + 4 * j); v[4 * j] = t[0]; v[4 * j + 1] = t[1]; v[4 * j + 2] = t[2]; v[4 * j + 3] = t[3]; }
#pragma unroll
      for (int j = 0; j < 32; ++j) ss += v[j] * v[j];
      ss += __shfl_xor(ss, 1); ss += __shfl_xor(ss, 2);
      const float rs = rsqrtf(ss * (1.f / 128.f) + EPS) * 0.8f;
      bf16_t* dst = Ob + (long)row * 1024 + qt * 32;
#pragma unroll
      for (int j = 0; j < 4; ++j) { const f32x4 g0 = *(const f32x4*)(gsub + qt * 32 + 8 * j), g1 = *(const f32x4*)(gsub + qt * 32 + 8 * j + 4);
          u32x4 w; w.x = cvtpk(v[8 * j] * rs * g0[0], v[8 * j + 1] * rs * g0[1]); w.y = cvtpk(v[8 * j + 2] * rs * g0[2], v[8 * j + 3] * rs * g0[3]);
          w.z = cvtpk(v[8 * j + 4] * rs * g1[0], v[8 * j + 5] * rs * g1[1]); w.w = cvtpk(v[8 * j + 6] * rs * g1[2], v[8 * j + 7] * rs * g1[3]);
          *(u32x4*)(dst + 8 * j) = w; } }
    __syncthreads();
#undef SLOAD
#undef SWRITE
#undef RESC
#undef PSM
}
}

namespace rt {
constexpr int KP = 528, VP = 144, SP = 528;
constexpr int KIMG = 0, VIMG = 128 * KP, SIMG = VIMG + 128 * VP, LDS_END = SIMG + 2 * 64 * SP;
static_assert(LDS_END <= LDS_BYTES, "retention LDS");
DI s16x4 trr(LAS unsigned char* p) { return __builtin_amdgcn_ds_read_tr16_b64_v4i16((LAS s16x4*)p); }
#define CAT8(L, H) (bf16x8){L[0], L[1], L[2], L[3], H[0], H[1], H[2], H[3]}

#define LBAR() do { asm volatile("s_waitcnt lgkmcnt(0)" ::: "memory"); __builtin_amdgcn_s_barrier(); asm volatile("" ::: "memory"); } while (0)
DI void ret_item(const bf16_t* __restrict__ P, bf16_t* __restrict__ Y, int S, int h, int sl, float lgf, float lgb, LAS unsigned char* lds) {
    const int tid = opaque_tid(), wid = tid >> 6, lane = tid & 63, r = lane & 31, h2 = lane >> 5;
    const int l15 = lane & 15, quad = lane >> 4, i0 = wid * 16, db = wid;
    const int gsub = (lane >> 4) & 1, tq = l15 >> 2, tp = l15 & 3;
    const int N = S / 128;
    bf16_t* Yl = Y + h * 512 + sl * 64 + l15;
    const bf16_t* Pq = P + (long)(i0 + l15) * 4096 + h * 256 + 8 * quad;
    const bf16_t* Pk = P + (long)(tid >> 5) * 4096 + 1024 + h * 256 + (tid & 31) * 8;
    const bf16_t* Pv = P + (long)(tid >> 3) * 4096 + 2048 + h * 512 + sl * 64 + (tid & 7) * 8;
#pragma unroll 1
    for (int dir = 0; dir < 2; ++dir) {
        const float lg = dir ? lgb : lgf;
        f32x16 st0, st1;
#pragma unroll
        for (int i = 0; i < 16; ++i) { st0[i] = 0.f; st1[i] = 0.f; }
        __syncthreads();
        for (int i = tid; i < 64 * SP / 16; i += 512) *(LAS u32x4*)(lds + SIMG + i * 16) = (u32x4){0u, 0u, 0u, 0u};
        const float cd = __builtin_amdgcn_exp2f(128.f * lg);
        bf16x8 qf[8], kr[8]; u32x4 vr[2];
#define RLOAD(n_) do { const long tk = (long)(n_) * 128 * 4096; \
            _Pragma("unroll") for (int s = 0; s < 8; ++s) qf[s] = *(const bf16x8*)(Pq + tk + 32 * s); \
            _Pragma("unroll") for (int i = 0; i < 8; ++i) kr[i] = *(const bf16x8*)(Pk + tk + (long)i * 16 * 4096); \
            _Pragma("unroll") for (int i = 0; i < 2; ++i) vr[i] = *(const u32x4*)(Pv + tk + (long)i * 64 * 4096); } while (0)
        RLOAD(dir ? N - 1 : 0);
        LBAR();
#pragma unroll 1
        for (int nn = 0; nn < N; ++nn) {
            const int n = dir ? N - 1 - nn : nn;
            const long tok0 = (long)n * 128;
            const int scur = SIMG + (nn & 1) * (64 * SP), snxt = SIMG + ((nn + 1) & 1) * (64 * SP);
            f32x4 yc[4];
#pragma unroll
            for (int nb = 0; nb < 4; ++nb) yc[nb] = (f32x4){0.f, 0.f, 0.f, 0.f};
            {
                const LAS unsigned char* sb = lds + scur + l15 * SP + 16 * quad;
                bf16x8 Bc[4], Bn[4];
#pragma unroll
                for (int nb = 0; nb < 4; ++nb) Bc[nb] = *(const LAS bf16x8*)(sb + 16 * nb * SP);
#pragma unroll
                for (int s = 0; s < 8; ++s) {
                    if (s < 7) {
#pragma unroll
                        for (int nb = 0; nb < 4; ++nb) Bn[nb] = *(const LAS bf16x8*)(sb + 16 * nb * SP + 64 * (s + 1)); }
                    __builtin_amdgcn_sched_barrier(0);
#pragma unroll
                    for (int nb = 0; nb < 4; ++nb) yc[nb] = __builtin_amdgcn_mfma_f32_16x16x32_bf16(qf[s], Bc[nb], yc[nb], 0, 0, 0);
                    __builtin_amdgcn_sched_barrier(0);
#pragma unroll
                    for (int nb = 0; nb < 4; ++nb) Bc[nb] = Bn[nb];
                }
            }
#pragma unroll
            for (int jj = 0; jj < 4; ++jj) { const int i = i0 + 4 * quad + jj; const float qd = 0.0625f * __builtin_amdgcn_exp2f(lg * (float)(dir ? 128 - i : i + 1));
#pragma unroll
                for (int nb = 0; nb < 4; ++nb) yc[nb][jj] *= qd; }
#pragma unroll
            for (int i = 0; i < 8; ++i) *(LAS bf16x8*)(lds + KIMG + ((tid >> 5) + 16 * i) * KP + (tid & 31) * 16) = kr[i];
#pragma unroll
            for (int i = 0; i < 2; ++i) { const int row = (tid >> 3) + 64 * i; const u32x4 w = vr[i];
                const float kd = __builtin_amdgcn_exp2f(lg * (float)(dir ? row : 127 - row));
                u32x4 o; o.x = cvtpk(bflo(w.x) * kd, bfhi(w.x) * kd); o.y = cvtpk(bflo(w.y) * kd, bfhi(w.y) * kd);
                o.z = cvtpk(bflo(w.z) * kd, bfhi(w.z) * kd); o.w = cvtpk(bflo(w.w) * kd, bfhi(w.w) * kd);
                *(LAS u32x4*)(lds + VIMG + row * VP + (tid & 7) * 16) = o; }
            LBAR();
            if (dir == 1) {
                float yf[16];
#pragma unroll
                for (int nb = 0; nb < 4; ++nb)
#pragma unroll
                    for (int jj = 0; jj < 4; ++jj) yf[nb * 4 + jj] = bf2f(Yl[(tok0 + i0 + 4 * quad + jj) * 2048 + 16 * nb]);
                const int i = i0 + l15;
#pragma unroll 1
                for (int t = 0; t < 4; ++t) {
                    f32x4 sc0 = (f32x4){0.f, 0.f, 0.f, 0.f}, sc1 = (f32x4){0.f, 0.f, 0.f, 0.f};
#pragma unroll
                    for (int s = 0; s < 8; ++s) {
                        const bf16x8 A0 = *(const LAS bf16x8*)(lds + KIMG + (32 * t + l15) * KP + (32 * s + 8 * quad) * 2);
                        const bf16x8 A1 = *(const LAS bf16x8*)(lds + KIMG + (32 * t + 16 + l15) * KP + (32 * s + 8 * quad) * 2);
                        sc0 = __builtin_amdgcn_mfma_f32_16x16x32_bf16(A0, qf[s], sc0, 0, 0, 0);
                        sc1 = __builtin_amdgcn_mfma_f32_16x16x32_bf16(A1, qf[s], sc1, 0, 0, 0);
                        if ((s & 3) == 3) __builtin_amdgcn_sched_barrier(0); }
#pragma unroll
                    for (int jj = 0; jj < 4; ++jj) {
                        { const int j = 32 * t + 4 * quad + jj; const float a = (i > j) ? ((float)(i - j) * lgf - (float)j * lgb) : (-(float)i * lgb);
                          float w = __builtin_amdgcn_exp2f(a) * 0.0625f; if (i == j) w *= 2.f; sc0[jj] *= w; }
                        { const int j = 32 * t + 16 + 4 * quad + jj; const float a = (i > j) ? ((float)(i - j) * lgf - (float)j * lgb) : (-(float)i * lgb);
                          float w = __builtin_amdgcn_exp2f(a) * 0.0625f; if (i == j) w *= 2.f; sc1[jj] *= w; } }
                    u32x4 pw; pw.x = cvtpk(sc0[0], sc0[1]); pw.y = cvtpk(sc0[2], sc0[3]); pw.z = cvtpk(sc1[0], sc1[1]); pw.w = cvtpk(sc1[2], sc1[3]);
#pragma unroll
                    for (int nb = 0; nb < 4; ++nb) {
                        LAS unsigned char* vb = lds + VIMG + (32 * t + 4 * quad + tq) * VP + (16 * nb) * 2 + 8 * tp;
                        const s16x4 lo = trr(vb), hi = trr(vb + 16 * VP);
                        yc[nb] = __builtin_amdgcn_mfma_f32_16x16x32_bf16(__builtin_bit_cast(bf16x8, pw), CAT8(lo, hi), yc[nb], 0, 0, 0); }
                }
#pragma unroll
                for (int nb = 0; nb < 4; ++nb)
#pragma unroll
                    for (int jj = 0; jj < 4; ++jj) yc[nb][jj] += yf[nb * 4 + jj];
            }
#pragma unroll
            for (int nb = 0; nb < 4; ++nb)
#pragma unroll
                for (int jj = 0; jj < 4; ++jj) Yl[(tok0 + i0 + 4 * quad + jj) * 2048 + 16 * nb] = (bf16_t)(cvtpk(yc[nb][jj], 0.f) & 0xffffu);
            if (nn + 1 < N) RLOAD(dir ? n - 1 : n + 1);
#pragma unroll
            for (int i = 0; i < 16; ++i) { st0[i] *= cd; st1[i] *= cd; }
#pragma unroll 2
            for (int s = 0; s < 8; ++s) {
                LAS unsigned char* ka = lds + KIMG + (16 * s + 8 * h2 + tq) * KP + (db * 32 + 16 * gsub) * 2 + 8 * tp;
                LAS unsigned char* va = lds + VIMG + (16 * s + 8 * h2 + tq) * VP + (16 * gsub) * 2 + 8 * tp;
                const s16x4 alo = trr(ka), ahi = trr(ka + 4 * KP);
                const s16x4 b0lo = trr(va), b0hi = trr(va + 4 * VP), b1lo = trr(va + 64), b1hi = trr(va + 4 * VP + 64);
                const bf16x8 A = CAT8(alo, ahi);
                st0 = __builtin_amdgcn_mfma_f32_32x32x16_bf16(A, CAT8(b0lo, b0hi), st0, 0, 0, 0);
                st1 = __builtin_amdgcn_mfma_f32_32x32x16_bf16(A, CAT8(b1lo, b1hi), st1, 0, 0, 0); }
#pragma unroll
            for (int g = 0; g < 4; ++g) {
                u32x2 w0, w1; w0.x = cvtpk(st0[4 * g], st0[4 * g + 1]); w0.y = cvtpk(st0[4 * g + 2], st0[4 * g + 3]); w1.x = cvtpk(st1[4 * g], st1[4 * g + 1]); w1.y = cvtpk(st1[4 * g + 2], st1[4 * g + 3]);
                *(LAS u32x2*)(lds + snxt + r * SP + (db * 32 + 8 * g + 4 * h2) * 2) = w0;
                *(LAS u32x2*)(lds + snxt + (32 + r) * SP + (db * 32 + 8 * g + 4 * h2) * 2) = w1; }
            LBAR();
        }
#undef RLOAD
    }
    __syncthreads();
}
}

DI void grid_barrier(unsigned* ctr, unsigned target) {
    __syncthreads();
    if (threadIdx.x == 0) {
        __builtin_amdgcn_fence(__ATOMIC_RELEASE, "agent");
        asm volatile("s_waitcnt vmcnt(0)" ::: "memory");
        __hip_atomic_fetch_add(ctr, 1u, __ATOMIC_RELAXED, __HIP_MEMORY_SCOPE_AGENT);
        while (__hip_atomic_load(ctr, __ATOMIC_RELAXED, __HIP_MEMORY_SCOPE_AGENT) < target) __builtin_amdgcn_s_sleep(100);
        __builtin_amdgcn_fence(__ATOMIC_ACQUIRE, "agent");
        asm volatile("s_waitcnt vmcnt(0)" ::: "memory");
    }
    __syncthreads();
}

__global__ __launch_bounds__(512, 2) void mega(Params p) {
    extern __shared__ __attribute__((aligned(16))) unsigned char shm[];
    LAS unsigned char* lds = (LAS unsigned char*)shm;
    cg::grid_group grid = cg::this_grid();
    unsigned* barctr = (unsigned*)(p.ws + WS_BAR); unsigned nbar = 0;
    const int G = gridDim.x, bid = blockIdx.x;
    const int vid = (bid & 7) * (G >> 3) + (bid >> 3);
    unsigned char* ws = p.ws;
    bf16_t* bufA = (bf16_t*)(ws + BUF_A); bf16_t* bufY = (bf16_t*)(ws + BUF_Y); bf16_t* bufBig = (bf16_t*)(ws + BUF_BIG);
    const int nph = NGROUPS * NPH;
    if (p.ph_lo < 0) grid.sync();
    for (int ph = p.ph_lo; ph < p.ph_hi && ph < nph; ++ph) {
        if (ph == 0) {
          if (PM & 1) {
            int tb = 0;
            wt_tiles(p.in[6], (bf16_t*)(ws + WT_IN0), 1024, 3072, lds, tb);
            wt_tiles(p.in[7], (bf16_t*)(ws + WT_OUT0), 1024, 1024, lds, tb);
            wt_tiles(p.in[13], (bf16_t*)(ws + WT_W10), 1024, 4096, lds, tb);
            wt_tiles(p.in[14], (bf16_t*)(ws + WT_W20), 4096, 1024, lds, tb);
            wt_tiles(p.in[19], (bf16_t*)(ws + WT_IN1), 1024, 6144, lds, tb);
            wt_tiles(p.in[20], (bf16_t*)(ws + WT_OUT1), 2048, 1024, lds, tb);
            wt_tiles(p.in[25], (bf16_t*)(ws + WT_W11), 1024, 4096, lds, tb);
            wt_tiles(p.in[26], (bf16_t*)(ws + WT_W21), 4096, 1024, lds, tb);
          }
        }
        {
            const int g = ph / NPH, s = ph % NPH;
            const float* xin = g == 0 ? p.in[0] : p.in[1];
            float* xout = p.out + (size_t)g * TG * 1024;
            const int S = g == 0 ? 2048 : 4096, BG = TG / S;
            int gk = -1; const bf16_t* gA = nullptr; const bf16_t* gB = nullptr; bf16_t* gO = nullptr; int gN = 0, gK = 0, gact = 0;
            switch (s) {
                case 0: if (bid == 0) { for (int i = threadIdx.x; i < 2048; i += 512) ((unsigned*)(ws + WS_NORM))[i] = 0u; }
                        if (PM & 2) phase_row(nullptr, xin, nullptr, bufA, nullptr, p.in[2], TG); break;
                case 1: gk = 1; gA = bufA; gB = (const bf16_t*)(ws + WT_IN0); gO = bufBig; gN = 3072; gK = 1024; break;
                case 2: phase_norms(bufBig, (unsigned*)(ws + WS_NORM), S); break;
                case 3: if (PM & 8) {
                    const int ln_ = threadIdx.x & 63;
                    const float s1 = wave_sum(p.in[8][ln_] * p.in[9][ln_]), s2 = wave_sum(p.in[10][ln_] * p.in[11][ln_]);
                    const float lam = expf(s1) - expf(s2) + 0.2f;
                    const int nQB = S / 128, nit = BG * 8 * nQB, NT = S / 64;
                    unsigned* qctr = barctr + 16 + g;
                    const unsigned* norms = (const unsigned*)(ws + WS_NORM);
                    LAS unsigned* itw = (LAS unsigned*)(lds + 67584);
                    for (;;) {
                        if (threadIdx.x == 0) *itw = __hip_atomic_fetch_add(qctr, 1u, __ATOMIC_RELAXED, __HIP_MEMORY_SCOPE_AGENT);
                        __syncthreads();
                        const int it = (int)*itw;
                        __syncthreads();
                        if (it >= nit) break;
                        const int hh = 7 - it / (BG * nQB), rem = it % (BG * nQB), b = rem / nQB, qb = rem % nQB;
                        const float msl = exp2f(-(float)(hh + 1)) * 1.4426950408889634f;
                        float W = 0.f;
#pragma unroll
                        for (int c = 0; c < 2; ++c) { const unsigned* n = norms + ((b * 8 + hh) * 2 + c) * 4;
                            const float q2 = __uint_as_float(__hip_atomic_load(n, __ATOMIC_RELAXED, __HIP_MEMORY_SCOPE_AGENT)), k2 = __uint_as_float(__hip_atomic_load(n + 1, __ATOMIC_RELAXED, __HIP_MEMORY_SCOPE_AGENT)),
                                        nz = __uint_as_float(__hip_atomic_load(n + 2, __ATOMIC_RELAXED, __HIP_MEMORY_SCOPE_AGENT));
                            W = fmaxf(W, (0.125f * 1.4426950408889634f * sqrtf(q2 * k2) * 1.001f + nz + 30.f) / msl); }
                        const int q0 = qb * 128;
                        const float lo_key = (float)q0 - W - 63.f, hi_key = (float)(q0 + 127) + W;
                        int tlo = lo_key <= 0.f ? 0 : (int)ceilf(lo_key * (1.f / 64.f)); int thi = hi_key >= (float)(S - 1) ? NT - 1 : (int)floorf(hi_key * (1.f / 64.f));
                        if (tlo > 2 * qb) tlo = 2 * qb; if (thi < 2 * qb + 1) thi = 2 * qb + 1;
                        if (((thi - tlo + 1) & 1) != 0) { if (thi < NT - 1) ++thi; else --tlo; }
                        const bf16_t* base = bufBig + (size_t)b * S * 3072;
                        da::attn_item(base + (size_t)q0 * 3072 + hh * 128, base + 1024 + hh * 128, base + 2048 + hh * 128,
                                      bufA + ((size_t)b * S + q0) * 1024 + hh * 128, q0, tlo, thi - tlo + 1, -msl, lam, p.in[12], lds);
                    }
                } break;
                case 4: gk = 1; gA = bufA; gB = (const bf16_t*)(ws + WT_OUT0); gO = bufY; gN = 1024; gK = 1024; break;
                case 5: if (PM & 2) phase_row(bufY, xin, xout, bufA, p.in[3], p.in[4], TG); break;
                case 6: gk = 1; gA = bufA; gB = (const bf16_t*)(ws + WT_W10); gO = bufBig; gN = 4096; gK = 1024; gact = 1; break;
                case 7: gk = 1; gA = bufBig; gB = (const bf16_t*)(ws + WT_W20); gO = bufA; gN = 1024; gK = 4096; break;
                case 8: if (PM & 2) phase_row(bufA, xout, xout, bufA, p.in[5], p.in[15], TG); break;
                case 9: gk = 1; gA = bufA; gB = (const bf16_t*)(ws + WT_IN1); gO = bufBig; gN = 4096; gK = 1024; break;
                case 10: if (PM & 16) {
                    const int nit = BG * 4 * 8;
                    for (int it = vid; it < nit; it += G) {
                        const int sl = it & 7, hh = (it >> 3) & 3, b = it >> 5;
                        const float lgf = log1pf(-expf(p.in[21][hh])) * 1.4426950408889634f, lgb = log1pf(-expf(p.in[22][hh])) * 1.4426950408889634f;
                        rt::ret_item(bufBig + (size_t)b * S * 4096, bufY + (size_t)b * S * 2048, S, hh, sl, lgf, lgb, lds);
                    }
                } break;
                case 11: gk = 1; gA = bufA; gB = (const bf16_t*)(ws + WT_IN1) + (size_t)4096 * 1024; gO = bufBig; gN = 2048; gK = 1024; break;
                case 12: if (PM & 32) phase_gn(bufY, bufBig, p.in[23], p.in[24], TG); break;
                case 13: gk = 1; gA = bufY; gB = (const bf16_t*)(ws + WT_OUT1); gO = bufA; gN = 1024; gK = 2048; break;
                case 14: if (PM & 2) phase_row(bufA, xout, xout, bufA, p.in[16], p.in[17], TG); break;
                case 15: gk = 1; gA = bufA; gB = (const bf16_t*)(ws + WT_W11); gO = bufBig; gN = 4096; gK = 1024; gact = 1; break;
                case 16: gk = 1; gA = bufBig; gB = (const bf16_t*)(ws + WT_W21); gO = bufA; gN = 1024; gK = 4096; break;
                case 17: if (PM & 2) phase_row(bufA, xout, xout, nullptr, p.in[18], nullptr, TG); break;
            }
            if ((PM & 4) && gk == 1) {
                pg8::Gemm gm; gm.A = gA; gm.Bt = gB; gm.M = TG; gm.N = gN; gm.K = gK;
                pg8::StaticOrder so; so.init(TG, gN, G, bid);
                pg8::EpiBf16R ep; ep.O = gO; ep.ldc = gN; ep.act = gact;
                pg8::gemm_phase<pg8::EpiBf16R, pg8::StaticOrder>(lds, gm, so, ep);
            }
        }
        if (ph + 1 < p.ph_hi && ph + 1 < nph) { ++nbar; grid_barrier(barctr, nbar * (unsigned)G); }
    }
}

extern "C" void kernel_launch(void* const* d_in, const int* in_sizes, int n_in, void* d_out, int out_size, void* d_ws, size_t ws_size, hipStream_t stream) {
    static int grid_blocks = 0;
    if (grid_blocks == 0) {
        if (n_in != 27 || ws_size < WS_END) { fprintf(stderr, "kernel_launch: unexpected n_in %d / ws_size %zu (need %zu)\n", n_in, ws_size, (size_t)WS_END); grid_blocks = -1; return; }
        int dev = 0, cus = 0, per_cu = 0;
        hipGetDevice(&dev);
        hipDeviceGetAttribute(&cus, hipDeviceAttributeMultiprocessorCount, dev);
        if (hipFuncSetAttribute((const void*)mega, hipFuncAttributeMaxDynamicSharedMemorySize, LDS_BYTES) != hipSuccess) { fprintf(stderr, "kernel_launch: hipFuncSetAttribute failed\n"); grid_blocks = -1; return; }
        hipOccupancyMaxActiveBlocksPerMultiprocessor(&per_cu, (const void*)mega, 512, LDS_BYTES);
        if (per_cu < 1) { fprintf(stderr, "kernel_launch: occupancy query says %d blocks/CU\n", per_cu); per_cu = 1; }
        grid_blocks = cus * per_cu;
        grid_blocks &= ~7;
        fprintf(stderr, "kernel_launch: grid %d (cus %d x %d)\n", grid_blocks, cus, per_cu);
    }
    if (grid_blocks < 0) return;
    Params p{};
    for (int i = 0; i < 27; ++i) p.in[i] = (const float*)d_in[i];
    p.out = (float*)d_out; p.ws = (unsigned char*)d_ws; p.ph_lo = 0; p.ph_hi = 1 << 20;
    if (hipMemsetAsync((char*)d_ws + WS_BAR, 0, 256, stream) != hipSuccess) { fprintf(stderr, "kernel_launch: memset failed\n"); return; }
    void* args[] = {&p};
    hipError_t e = hipLaunchCooperativeKernel((const void*)mega, dim3(grid_blocks), dim3(512), args, LDS_BYTES, stream);
    if (e != hipSuccess) fprintf(stderr, "cooperative launch failed: %s (grid %d)\n", hipGetErrorString(e), grid_blocks);
}
```

```cpp
#include <hip/hip_runtime.h>
#include <hip/hip_cooperative_groups.h>
#include <cstdio>
namespace cg = cooperative_groups;

#define LAS __attribute__((address_space(3)))
#define DI __device__ __forceinline__
typedef unsigned short bf16_t;
typedef short bf16x8 __attribute__((ext_vector_type(8)));
typedef short s16x4 __attribute__((ext_vector_type(4)));
typedef float f32x4 __attribute__((ext_vector_type(4)));
typedef float f32x16 __attribute__((ext_vector_type(16)));
typedef unsigned u32x4 __attribute__((ext_vector_type(4)));
typedef unsigned u32x2 __attribute__((ext_vector_type(2)));

constexpr int TG = 65536;
constexpr int NGROUPS = 2;
constexpr int NPH = 18;
constexpr int LDS_BYTES = 153600;
constexpr float EPS = 1e-6f;
#ifndef PM
#define PM 63
#endif

constexpr size_t WT_IN0 = 0, WT_OUT0 = 6291456, WT_W10 = 8388608, WT_W20 = 16777216, WT_IN1 = 25165824, WT_OUT1 = 37748736,
                 WT_W11 = 41943040, WT_W21 = 50331648, BUF_A = 58720256, BUF_Y = 192937984, BUF_BIG = 461373440, WS_BAR = 998244352, WS_NORM = 998244352 + 1024, WS_END = 998244352 + 1024 + 8192;

struct Params {
    const float* in[27];
    float* out;
    unsigned char* ws;
    int ph_lo, ph_hi;
};

DI unsigned cvtpk(float lo, float hi) { unsigned r; asm volatile("v_cvt_pk_bf16_f32 %0, %1, %2" : "=v"(r) : "v"(lo), "v"(hi)); return r; }
DI float bf2f(unsigned short b) { return __uint_as_float(((unsigned)b) << 16); }
DI float bflo(unsigned w) { return __uint_as_float(w << 16); }
DI float bfhi(unsigned w) { return __uint_as_float(w & 0xffff0000u); }
DI float wave_sum(float v) {
#pragma unroll
    for (int o = 32; o; o >>= 1) v += __shfl_xor(v, o);
    return v;
}
DI int opaque_tid() { int t = threadIdx.x; asm volatile("" : "+v"(t)); return t; }
DI int crow(int r, int hi) { return (r & 3) + 8 * (r >> 2) + 4 * hi; }

namespace pg8 {
constexpr int BM = 256, BK = 64, HALF = 128, HTB = HALF * BK * 2, STAGE_BYTES = 8 * HTB, NXCD = 8, WGM = 8;
DI int lds_byte(int r, int c) { const int st = (r >> 4) * 2 + (c >> 5), rr = r & 15, cc = c & 31, ob = rr * 64 + cc * 2; return st * 1024 + (ob ^ (((ob >> 9) & 1) << 5)); }
DI void stage_rc(int b, int& R, int& C) { const int st = b / 1024, sb = b % 1024, swz = sb ^ (((sb >> 9) & 1) << 5); R = (st >> 1) * 16 + swz / 64; C = (st & 1) * 32 + (swz % 64) / 2; }
DI int perm32(int rho) { const int n = rho >> 4, i = rho & 15; return 8 * (i >> 2) + 4 * n + (i & 3); }
struct Unit { int pm, pn; };
struct Gemm { const bf16_t* A; const bf16_t* Bt; int M, N, K; };
struct StaticOrder {
    int nM, nN, nwg, G, c;
    DI void init(int M, int N, int G_, int c_) { nM = M / BM; nN = N / BM; nwg = nM * nN; G = G_; c = c_; }
    DI bool next(int i, Unit& u) const {
        const long L = (long)i * G + c; if (L >= nwg) return false;
        int wgid = (int)L; { const int q = nwg / NXCD, r = nwg % NXCD, xcd = wgid % NXCD, off = wgid / NXCD; wgid = (xcd < r ? xcd * (q + 1) : r * (q + 1) + (xcd - r) * q) + off; }
        const int nig = WGM * nN, gid = wgid / nig, fm = gid * WGM, gsz = (nM - fm) < WGM ? (nM - fm) : WGM;
        u.pm = fm + ((wgid % nig) % gsz); u.pn = (wgid % nig) / gsz; return true;
    }
};
struct EpiBf16R {
    static constexpr bool PERM = true;
    bf16_t* O; int ldc; int act;
    DI void operator()(const f32x4 (&acc)[2][2][4][2], const Unit& u, int wr, int wc, int fr, int fq) const {
        const int row0 = u.pm * BM + wr * 64 + fr; const int col0 = u.pn * BM + wc * 32 + 8 * fq;
#pragma unroll
        for (int ai = 0; ai < 2; ++ai)
#pragma unroll
            for (int m = 0; m < 4; ++m) { bf16_t* rowp = O + (size_t)(row0 + ai * HALF + m * 16) * ldc + col0;
#pragma unroll
                for (int bj = 0; bj < 2; ++bj) { f32x4 v0 = acc[ai][bj][m][0], v1 = acc[ai][bj][m][1];
                    if (act) {
#pragma unroll
                        for (int j = 0; j < 4; ++j) { float a = fmaxf(v0[j], 0.f), b = fmaxf(v1[j], 0.f); v0[j] = a * a; v1[j] = b * b; } }
                    u32x4 w; w.x = cvtpk(v0[0], v0[1]); w.y = cvtpk(v0[2], v0[3]); w.z = cvtpk(v1[0], v1[1]); w.w = cvtpk(v1[2], v1[3]);
                    *(u32x4*)(rowp + bj * HALF) = w; } }
    }
};

template <class Epi, class Sched>
DI void gemm_phase(LAS unsigned char* lds, const Gemm g, const Sched& S, const Epi& E) {
    const int tid = opaque_tid(), wid = __builtin_amdgcn_readfirstlane(tid >> 6), lane = tid & 63, wr = wid >> 2, wc = wid & 3, fr = lane & 15, fq = lane >> 4;
    const int K = g.K, nt = K / BK;
    unsigned voffA[2], voffB[2];
#pragma unroll
    for (int i = 0; i < 2; ++i) { int R, C; stage_rc(tid * 16 + i * 8192, R, C); const int Rb = Epi::PERM ? ((R & ~31) + perm32(R & 31)) : R;
        voffA[i] = (unsigned)(R * K + C) * 2u; voffB[i] = (unsigned)(Rb * K + C) * 2u; }
    const size_t kstep = (size_t)(BK * 2);
    const size_t hstep = (size_t)HALF * K * 2;
    const size_t tstep = 2 * hstep;
    const unsigned ldsw = (unsigned)wid * 1024u;
    const int aoff = lds_byte(wr * 64 + fr, fq * 8), boff = lds_byte(wc * 32 + fr, fq * 8);
#define PG8_SA(b, h) (((b) * 2 + (h)) * HTB)
#define PG8_SB(b, h) ((4 + (b) * 2 + (h)) * HTB)
#define PG8_STAGE(bufoff, gbase, voff) do { _Pragma("unroll") for (int _i = 0; _i < 2; ++_i) \
        __builtin_amdgcn_global_load_lds((const unsigned*)((const char*)(gbase) + (voff)[_i]), (LAS unsigned*)(lds + (bufoff) + ldsw + _i * 8192), 16, 0, 0); } while (0)
#define PG8_LDA(dst, b, h) do { _Pragma("unroll") for (int m = 0; m < 4; ++m) _Pragma("unroll") for (int k = 0; k < 2; ++k) dst[m][k] = *(const LAS bf16x8*)(lds + PG8_SA(b, h) + aoff + m * 2048 + k * 1024); } while (0)
#define PG8_LDB(dst, b, h) do { _Pragma("unroll") for (int n = 0; n < 2; ++n) _Pragma("unroll") for (int k = 0; k < 2; ++k) dst[n][k] = *(const LAS bf16x8*)(lds + PG8_SB(b, h) + boff + n * 2048 + k * 1024); } while (0)
#define PG8_MMA(ai, bj, At, Bt) do { __builtin_amdgcn_s_setprio(1); _Pragma("unroll") for (int m = 0; m < 4; ++m) _Pragma("unroll") for (int n = 0; n < 2; ++n) _Pragma("unroll") for (int k = 0; k < 2; ++k) \
        acc[ai][bj][m][n] = __builtin_amdgcn_mfma_f32_16x16x32_bf16(Bt[n][k], At[m][k], acc[ai][bj][m][n], 0, 0, 0); __builtin_amdgcn_s_setprio(0); } while (0)
#define PG8_WAIT_V(n) asm volatile("s_waitcnt vmcnt(" #n ")" ::: "memory")
#define PG8_WAIT_L(n) asm volatile("s_waitcnt lgkmcnt(" #n ")" ::: "memory")
#define PG8_BAR __builtin_amdgcn_s_barrier()
#define PG8_SCHED __builtin_amdgcn_sched_barrier(0)
    Unit cur, nxt; int ui = 0;
    if (!S.next(0, cur)) return;
    f32x4 acc[2][2][4][2];
#pragma unroll
    for (int a = 0; a < 2; ++a)
#pragma unroll
        for (int b = 0; b < 2; ++b)
#pragma unroll
            for (int m = 0; m < 4; ++m)
#pragma unroll
                for (int n = 0; n < 2; ++n) acc[a][b][m][n] = (f32x4){0.f, 0.f, 0.f, 0.f};
    bf16x8 At[4][2], B0[2][2], B1[2][2];
    const char* cA = (const char*)g.A + (size_t)cur.pm * tstep; const char* cB = (const char*)g.Bt + (size_t)cur.pn * tstep;
    PG8_STAGE(PG8_SB(0, 0), cB, voffB); PG8_STAGE(PG8_SA(0, 0), cA, voffA); PG8_STAGE(PG8_SB(0, 1), cB + hstep, voffB); PG8_STAGE(PG8_SA(0, 1), cA + hstep, voffA);
    if (wr == 1) PG8_BAR;
    PG8_WAIT_V(4); PG8_BAR;
    PG8_STAGE(PG8_SB(1, 0), cB + kstep, voffB); PG8_STAGE(PG8_SA(1, 0), cA + kstep, voffA); PG8_STAGE(PG8_SB(1, 1), cB + hstep + kstep, voffB);
    PG8_WAIT_V(6); PG8_BAR;
    for (;;) {
        const bool has_next = S.next(ui + 1, nxt);
        const char* nA = has_next ? (const char*)g.A + (size_t)nxt.pm * tstep : cA; const char* nB = has_next ? (const char*)g.Bt + (size_t)nxt.pn * tstep : cB;
        for (int t = 0; t < nt; t += 2) {
            const bool last = (t == nt - 2);
            const char* a1 = cA + (size_t)(t + 1) * kstep;
            const char* a2 = last ? nA : cA + (size_t)(t + 2) * kstep; const char* b2 = last ? nB : cB + (size_t)(t + 2) * kstep;
            const char* a3 = a2 + kstep; const char* b3 = b2 + kstep;
            PG8_LDB(B0, 0, 0); PG8_SCHED; PG8_LDA(At, 0, 0); PG8_STAGE(PG8_SA(1, 1), a1 + hstep, voffA);
            PG8_WAIT_L(8); PG8_BAR; PG8_WAIT_L(0); PG8_MMA(0, 0, At, B0); PG8_BAR; PG8_SCHED;
            PG8_LDB(B1, 0, 1); PG8_STAGE(PG8_SB(0, 0), b2, voffB);
            PG8_BAR; PG8_WAIT_L(0); PG8_MMA(0, 1, At, B1); PG8_BAR;
            PG8_LDA(At, 0, 1); PG8_STAGE(PG8_SA(0, 0), a2, voffA);
            PG8_BAR; PG8_WAIT_L(0); PG8_MMA(1, 0, At, B0); PG8_BAR; PG8_SCHED;
            PG8_STAGE(PG8_SB(0, 1), b2 + hstep, voffB);
            PG8_WAIT_V(6); PG8_BAR; PG8_MMA(1, 1, At, B1); PG8_BAR;
            PG8_LDB(B0, 1, 0); PG8_SCHED; PG8_LDA(At, 1, 0); PG8_STAGE(PG8_SA(0, 1), a2 + hstep, voffA);
            PG8_WAIT_L(8); PG8_BAR; PG8_WAIT_L(0); PG8_MMA(0, 0, At, B0); PG8_BAR; PG8_SCHED;
            PG8_LDB(B1, 1, 1); PG8_STAGE(PG8_SB(1, 0), b3, voffB);
            PG8_BAR; PG8_WAIT_L(0); PG8_MMA(0, 1, At, B1); PG8_BAR;
            PG8_LDA(At, 1, 1); PG8_STAGE(PG8_SA(1, 0), a3, voffA);
            PG8_BAR; PG8_WAIT_L(0); PG8_MMA(1, 0, At, B0); PG8_BAR; PG8_SCHED;
            PG8_STAGE(PG8_SB(1, 1), b3 + hstep, voffB);
            PG8_WAIT_V(6); PG8_BAR; PG8_MMA(1, 1, At, B1); PG8_BAR;
        }
        E(acc, cur, wr, wc, fr, fq);
        if (!has_next) break;
#pragma unroll
        for (int a = 0; a < 2; ++a)
#pragma unroll
            for (int b = 0; b < 2; ++b)
#pragma unroll
                for (int m = 0; m < 4; ++m)
#pragma unroll
                    for (int n = 0; n < 2; ++n) acc[a][b][m][n] = (f32x4){0.f, 0.f, 0.f, 0.f};
        cur = nxt; cA = nA; cB = nB; ++ui;
    }
    PG8_WAIT_V(0);
    if (wr == 0) PG8_BAR;
    PG8_BAR;
#undef PG8_SA
#undef PG8_SB
#undef PG8_STAGE
#undef PG8_LDA
#undef PG8_LDB
#undef PG8_MMA
#undef PG8_WAIT_V
#undef PG8_WAIT_L
#undef PG8_BAR
#undef PG8_SCHED
}
}

DI void wt_tiles(const float* __restrict__ W, bf16_t* __restrict__ Wt, int K, int N, LAS unsigned char* lds, int& tile_base) {
    LAS float* t = (LAS float*)lds;
    const int nk = K / 64, nn = N / 64, ntl = nk * nn, tid = opaque_tid();
    for (int tl = ((int)blockIdx.x - tile_base % (int)gridDim.x + (int)gridDim.x) % (int)gridDim.x; tl < ntl; tl += gridDim.x) {
        const int tk = tl / nn, tn = tl % nn;
        { const int kk = tid >> 3, c8 = (tid & 7) * 8; const float* src = W + (size_t)(tk * 64 + kk) * N + tn * 64 + c8;
          const f32x4 a = *(const f32x4*)src, b = *(const f32x4*)(src + 4);
          LAS float* d = t + kk * 65 + c8; d[0] = a[0]; d[1] = a[1]; d[2] = a[2]; d[3] = a[3]; d[4] = b[0]; d[5] = b[1]; d[6] = b[2]; d[7] = b[3]; }
        __syncthreads();
        { const int n = tid >> 3, k8 = (tid & 7) * 8; float v[8];
#pragma unroll
          for (int j = 0; j < 8; ++j) v[j] = t[(k8 + j) * 65 + n];
          u32x4 w; w.x = cvtpk(v[0], v[1]); w.y = cvtpk(v[2], v[3]); w.z = cvtpk(v[4], v[5]); w.w = cvtpk(v[6], v[7]);
          *(u32x4*)(Wt + (size_t)(tn * 64 + n) * K + tk * 64 + k8) = w; }
        __syncthreads();
    }
    tile_base += ntl;
}

DI void phase_row(const bf16_t* m, const float* xsrc, float* xdst, bf16_t* hn, const float* gpost, const float* gnext, int rows) {
    const int tid_ = opaque_tid(); const int lane = tid_ & 63, wid = tid_ >> 6;
    const int nw = gridDim.x * 8;
    for (int row0 = blockIdx.x * 8 + wid; row0 < rows; row0 += 2 * nw) {
        const int rws[2] = {row0, row0 + nw < rows ? row0 + nw : row0};
        float x[2][16]; u32x4 mw[2][2];
#pragma unroll
        for (int q = 0; q < 2; ++q)
#pragma unroll
            for (int c = 0; c < 2; ++c) { const float* s = xsrc + (size_t)rws[q] * 1024 + c * 512 + lane * 8; const f32x4 a = *(const f32x4*)s, b = *(const f32x4*)(s + 4);
#pragma unroll
                for (int j = 0; j < 4; ++j) { x[q][c * 8 + j] = a[j]; x[q][c * 8 + 4 + j] = b[j]; } }
        if (m) {
#pragma unroll
            for (int q = 0; q < 2; ++q)
#pragma unroll
                for (int c = 0; c < 2; ++c) mw[q][c] = *(const u32x4*)(m + (size_t)rws[q] * 1024 + c * 512 + lane * 8);
            f32x4 ga[2], gb[2];
#pragma unroll
            for (int c = 0; c < 2; ++c) { const float* gp = gpost + c * 512 + lane * 8; ga[c] = *(const f32x4*)gp; gb[c] = *(const f32x4*)(gp + 4); }
#pragma unroll
            for (int q = 0; q < 2; ++q) {
                float mv[16]; float ss = 0.f;
#pragma unroll
                for (int c = 0; c < 2; ++c)
#pragma unroll
                    for (int j = 0; j < 4; ++j) { mv[c * 8 + 2 * j] = bflo(mw[q][c][j]); mv[c * 8 + 2 * j + 1] = bfhi(mw[q][c][j]); }
#pragma unroll
                for (int j = 0; j < 16; ++j) ss += mv[j] * mv[j];
                ss = wave_sum(ss);
                const float r = rsqrtf(ss * (1.f / 1024.f) + EPS);
#pragma unroll
                for (int c = 0; c < 2; ++c)
#pragma unroll
                    for (int j = 0; j < 4; ++j) { x[q][c * 8 + j] += mv[c * 8 + j] * r * ga[c][j]; x[q][c * 8 + 4 + j] += mv[c * 8 + 4 + j] * r * gb[c][j]; }
            }
        }
        if (xdst) {
#pragma unroll
            for (int q = 0; q < 2; ++q)
#pragma unroll
                for (int c = 0; c < 2; ++c) { float* d = xdst + (size_t)rws[q] * 1024 + c * 512 + lane * 8;
                    *(f32x4*)d = (f32x4){x[q][c * 8], x[q][c * 8 + 1], x[q][c * 8 + 2], x[q][c * 8 + 3]}; *(f32x4*)(d + 4) = (f32x4){x[q][c * 8 + 4], x[q][c * 8 + 5], x[q][c * 8 + 6], x[q][c * 8 + 7]}; }
        }
        if (hn) {
            f32x4 ga[2], gb[2];
#pragma unroll
            for (int c = 0; c < 2; ++c) { const float* gp = gnext + c * 512 + lane * 8; ga[c] = *(const f32x4*)gp; gb[c] = *(const f32x4*)(gp + 4); }
#pragma unroll
            for (int q = 0; q < 2; ++q) {
                float ss = 0.f;
#pragma unroll
                for (int j = 0; j < 16; ++j) ss += x[q][j] * x[q][j];
                ss = wave_sum(ss);
                const float r = rsqrtf(ss * (1.f / 1024.f) + EPS);
#pragma unroll
                for (int c = 0; c < 2; ++c) {
                    u32x4 w; w.x = cvtpk(x[q][c * 8] * r * ga[c][0], x[q][c * 8 + 1] * r * ga[c][1]); w.y = cvtpk(x[q][c * 8 + 2] * r * ga[c][2], x[q][c * 8 + 3] * r * ga[c][3]);
                    w.z = cvtpk(x[q][c * 8 + 4] * r * gb[c][0], x[q][c * 8 + 5] * r * gb[c][1]); w.w = cvtpk(x[q][c * 8 + 6] * r * gb[c][2], x[q][c * 8 + 7] * r * gb[c][3]);
                    *(u32x4*)(hn + (size_t)rws[q] * 1024 + c * 512 + lane * 8) = w; }
            }
        }
    }
}

DI void phase_gn(bf16_t* y, const bf16_t* big, const float* gw, const float* gb, int rows) {
    const int tid_ = opaque_tid(); const int lane = tid_ & 63, wid = tid_ >> 6;
    for (int row = blockIdx.x * 8 + wid; row < rows; row += gridDim.x * 8) {
        u32x4 yw[4], gq[4];
#pragma unroll
        for (int hh = 0; hh < 4; ++hh) { yw[hh] = *(const u32x4*)(y + (size_t)row * 2048 + hh * 512 + lane * 8); gq[hh] = *(const u32x4*)(big + (size_t)row * 2048 + hh * 512 + lane * 8); }
#pragma unroll
        for (int hh = 0; hh < 4; ++hh) {
            bf16_t* yp = y + (size_t)row * 2048 + hh * 512 + lane * 8;
            float v[8], g[8];
#pragma unroll
            for (int j = 0; j < 4; ++j) { v[2 * j] = bflo(yw[hh][j]); v[2 * j + 1] = bfhi(yw[hh][j]); g[2 * j] = bflo(gq[hh][j]); g[2 * j + 1] = bfhi(gq[hh][j]); }
            float s = 0.f;
#pragma unroll
            for (int j = 0; j < 8; ++j) s += v[j];
            const float mu = wave_sum(s) * (1.f / 512.f);
            float q = 0.f;
#pragma unroll
            for (int j = 0; j < 8; ++j) { v[j] -= mu; q += v[j] * v[j]; }
            const float rs = rsqrtf(wave_sum(q) * (1.f / 512.f) + EPS);
            const float* wp = gw + hh * 512 + lane * 8; const float* bp = gb + hh * 512 + lane * 8;
            const f32x4 w0 = *(const f32x4*)wp, w1 = *(const f32x4*)(wp + 4), b0 = *(const f32x4*)bp, b1 = *(const f32x4*)(bp + 4);
            float o[8];
#pragma unroll
            for (int j = 0; j < 8; ++j) { const float wj = j < 4 ? w0[j & 3] : w1[j & 3], bj = j < 4 ? b0[j & 3] : b1[j & 3];
                const float sg = g[j] / (1.f + __expf(-g[j])); o[j] = sg * (v[j] * rs * wj + bj); }
            u32x4 ow; ow.x = cvtpk(o[0], o[1]); ow.y = cvtpk(o[2], o[3]); ow.z = cvtpk(o[4], o[5]); ow.w = cvtpk(o[6], o[7]);
            *(u32x4*)yp = ow;
        }
    }
}

DI void phase_norms(const bf16_t* __restrict__ qkv, unsigned* norms, int S) {
    const int tid = opaque_tid(), lane = tid & 63, wid = tid >> 6;
    for (int chunk = blockIdx.x * 8 + wid; chunk < TG / 32; chunk += gridDim.x * 8) {
        const int t0 = chunk * 32, b = t0 / S;
        float q2 = 0.f, k2 = 0.f, nz = 0.f;
#pragma unroll 2
        for (int t = 0; t < 32; ++t) {
            const bf16_t* row = qkv + (size_t)(t0 + t) * 3072 + lane * 16;
            const u32x4 qa = *(const u32x4*)row, qb = *(const u32x4*)(row + 8), ka = *(const u32x4*)(row + 1024), kb = *(const u32x4*)(row + 1032);
            float sq = 0.f, sk = 0.f, sd = 0.f;
#pragma unroll
            for (int j = 0; j < 4; ++j) {
                { const float a = bflo(qa[j]), c = bfhi(qa[j]), d = bflo(ka[j]), e = bfhi(ka[j]); sq += a * a + c * c; sk += d * d + e * e; sd += a * d + c * e; }
                { const float a = bflo(qb[j]), c = bfhi(qb[j]), d = bflo(kb[j]), e = bfhi(kb[j]); sq += a * a + c * c; sk += d * d + e * e; sd += a * d + c * e; } }
            sq += __shfl_xor(sq, 1); sk += __shfl_xor(sk, 1); sd += __shfl_xor(sd, 1);
            sq += __shfl_xor(sq, 2); sk += __shfl_xor(sk, 2); sd += __shfl_xor(sd, 2);
            q2 = fmaxf(q2, sq); k2 = fmaxf(k2, sk); nz = fmaxf(nz, -sd * (0.125f * 1.4426950408889634f));
        }
        if ((lane & 3) == 0) { unsigned* n = norms + ((b * 8 + (lane >> 3)) * 2 + ((lane & 7) >> 2)) * 4;
            atomicMax(n, __float_as_uint(q2)); atomicMax(n + 1, __float_as_uint(k2)); atomicMax(n + 2, __float_as_uint(nz)); }
    }
}

namespace da {
constexpr int SHM_V = 64 * 128 * 2, SHM_K = 64 * 128 * 2, LDQ = 3072, LDK = 3072;
constexpr float C = 0.125f * 1.4426950408889634f;
constexpr float THRZ = 8.f * 1.4426950408889634f;
#define KSWZ(row, colB) ((row) * 256 + ((colB) ^ (((row) & 7) << 4)))
#define SBAR() __builtin_amdgcn_sched_barrier(0)

DI void partialSM(f32x16& p0, f32x16& p1, float& m_reg, float& mn, float& alpha, float tb, float nsl) {
#pragma unroll
    for (int r = 0; r < 16; ++r) { const float t0 = tb + (float)((r & 3) + 8 * (r >> 2)); const float t1 = t0 + 32.f;
        p0[r] = fmaf(p0[r], C, nsl * fabsf(t0)); p1[r] = fmaf(p1[r], C, nsl * fabsf(t1)); }
    float pmax = p0[0];
#pragma unroll
    for (int r = 1; r < 16; ++r) pmax = fmaxf(pmax, p0[r]);
#pragma unroll
    for (int r = 0; r < 16; ++r) pmax = fmaxf(pmax, p1[r]);
    { auto rr = __builtin_amdgcn_permlane32_swap(__float_as_uint(pmax), __float_as_uint(pmax), false, false);
      pmax = fmaxf(__uint_as_float(rr[0]), __uint_as_float(rr[1])); }
    if (__builtin_expect(__all(pmax - m_reg <= THRZ), 1)) { mn = m_reg; alpha = 1.f; }
    else { mn = fmaxf(m_reg, pmax); alpha = __builtin_amdgcn_exp2f(m_reg - mn); m_reg = mn; }
#pragma unroll
    for (int r = 0; r < 16; ++r) { p0[r] -= mn; p1[r] -= mn; }
#pragma unroll
    for (int r = 0; r < 16; ++r) p0[r] = __builtin_amdgcn_exp2f(p0[r]);
}
DI void partialSM_lin(f32x16& p0, f32x16& p1, float& m_reg, float& mn, float& alpha, float tb, float sgn_nsl) {
    asm volatile("" : "+v"(sgn_nsl));
#pragma unroll
    for (int r = 0; r < 16; ++r) { const float k = sgn_nsl * (float)((r & 3) + 8 * (r >> 2)); p0[r] = fmaf(p0[r], C, k); p1[r] = fmaf(p1[r], C, k); }
    float mx0 = p0[0], mx1 = p1[0];
#pragma unroll
    for (int r = 1; r < 16; ++r) { mx0 = fmaxf(mx0, p0[r]); mx1 = fmaxf(mx1, p1[r]); }
    const float base0 = sgn_nsl * tb, base1 = base0 + 32.f * sgn_nsl;
    float pmax = fmaxf(mx0 + base0, mx1 + base1);
    { auto rr = __builtin_amdgcn_permlane32_swap(__float_as_uint(pmax), __float_as_uint(pmax), false, false);
      pmax = fmaxf(__uint_as_float(rr[0]), __uint_as_float(rr[1])); }
    if (__builtin_expect(__all(pmax - m_reg <= THRZ), 1)) { mn = m_reg; alpha = 1.f; }
    else { mn = fmaxf(m_reg, pmax); alpha = __builtin_amdgcn_exp2f(m_reg - mn); m_reg = mn; }
    const float d0 = mn - base0, d1 = mn - base1;
#pragma unroll
    for (int r = 0; r < 16; ++r) { p0[r] -= d0; p1[r] -= d1; }
#pragma unroll
    for (int r = 0; r < 16; ++r) p0[r] = __builtin_amdgcn_exp2f(p0[r]);
}
DI void finishSM(f32x16& p0, f32x16& p1, float alpha, float& l_reg, bf16x8& pa0, bf16x8& pa1, bf16x8& pa2, bf16x8& pa3) {
#pragma unroll
    for (int r = 0; r < 16; ++r) p1[r] = __builtin_amdgcn_exp2f(p1[r]);
    float ps = 0;
#pragma unroll
    for (int r = 0; r < 16; ++r) ps += p0[r];
#pragma unroll
    for (int r = 0; r < 16; ++r) ps += p1[r];
    { auto rr = __builtin_amdgcn_permlane32_swap(__float_as_uint(ps), __float_as_uint(ps), false, false);
      ps = __uint_as_float(rr[0]) + __uint_as_float(rr[1]); }
    l_reg = l_reg * alpha + ps;
#define PK4(P, BASE, OUT) do { unsigned a0 = cvtpk(P[BASE + 0], P[BASE + 1]), a1 = cvtpk(P[BASE + 2], P[BASE + 3]);   \
    unsigned b0 = cvtpk(P[BASE + 4], P[BASE + 5]), b1 = cvtpk(P[BASE + 6], P[BASE + 7]);                              \
    auto r0 = __builtin_amdgcn_permlane32_swap(a0, b0, false, false); auto r1 = __builtin_amdgcn_permlane32_swap(a1, b1, false, false); \
    u32x4 w = {r0[0], r1[0], r0[1], r1[1]}; OUT = __builtin_bit_cast(bf16x8, w); } while (0)
    PK4(p0, 0, pa0); PK4(p0, 8, pa1); PK4(p1, 0, pa2); PK4(p1, 8, pa3);
#undef PK4
}
DI void qkt(f32x16& p0, f32x16& p1, const LAS unsigned char* Ks, const bf16x8* qr, int r32, int hi, int cmap) {
#pragma unroll
    for (int r = 0; r < 16; ++r) { p0[r] = 0.f; p1[r] = 0.f; }
#pragma unroll
    for (int d0 = 0; d0 < 4; ++d0) { const int cb = (cmap * 64 + d0 * 16 + hi * 8) * 2;
        const bf16x8 b0 = *(const LAS bf16x8*)(Ks + KSWZ(r32, cb));
        const bf16x8 b1 = *(const LAS bf16x8*)(Ks + KSWZ(32 + r32, cb));
        p0 = __builtin_amdgcn_mfma_f32_32x32x16_bf16(b0, qr[d0], p0, 0, 0, 0);
        p1 = __builtin_amdgcn_mfma_f32_32x32x16_bf16(b1, qr[d0], p1, 0, 0, 0); }
}
DI int v_st(int k, int c) { const int kk = (k & ~0xC) | ((k & 4) << 1) | ((k & 8) >> 1); return ((kk >> 3) * 4 + (c >> 5)) * 512 + ((kk & 7) * 32 + (c & 31)) * 2; }
DI int v_rd_base(int lane) { return ((lane & 3) << 3) | (((lane >> 2) & 3) << 6) | (((lane >> 4) & 1) << 5) | (((lane >> 5) & 1) << 8); }
constexpr int v_rd_off(int d0, int ks, int half) { return d0 * 512 + ks * 4096 + half * 2048; }
template <int OFF> DI s16x4 tr_read(int vb) { s16x4 r; asm volatile("ds_read_b64_tr_b16 %0, %1 offset:%2" : "=&v"(r) : "v"(vb), "i"(OFF) : "memory"); return r; }
template <int D0> DI void pv_one(f32x16& od, int vb, bf16x8 pa0, bf16x8 pa1, bf16x8 pa2, bf16x8 pa3) {
    const s16x4 l0 = tr_read<v_rd_off(D0, 0, 0)>(vb), h0 = tr_read<v_rd_off(D0, 0, 1)>(vb), l1 = tr_read<v_rd_off(D0, 1, 0)>(vb), h1 = tr_read<v_rd_off(D0, 1, 1)>(vb);
    const s16x4 l2 = tr_read<v_rd_off(D0, 2, 0)>(vb), h2 = tr_read<v_rd_off(D0, 2, 1)>(vb), l3 = tr_read<v_rd_off(D0, 3, 0)>(vb), h3 = tr_read<v_rd_off(D0, 3, 1)>(vb);
    asm volatile("s_waitcnt lgkmcnt(0)" ::: "memory"); SBAR();
#define PK(L, H) (bf16x8){L[0], L[1], L[2], L[3], H[0], H[1], H[2], H[3]}
    od = __builtin_amdgcn_mfma_f32_32x32x16_bf16(pa0, PK(l0, h0), od, 0, 0, 0);
    od = __builtin_amdgcn_mfma_f32_32x32x16_bf16(pa1, PK(l1, h1), od, 0, 0, 0);
    od = __builtin_amdgcn_mfma_f32_32x32x16_bf16(pa2, PK(l2, h2), od, 0, 0, 0);
    od = __builtin_amdgcn_mfma_f32_32x32x16_bf16(pa3, PK(l3, h3), od, 0, 0, 0);
#undef PK
}
DI void pv_d0(f32x16* o, int vb, bf16x8 pa0, bf16x8 pa1, bf16x8 pa2, bf16x8 pa3) {
    pv_one<0>(o[0], vb, pa0, pa1, pa2, pa3); pv_one<1>(o[1], vb, pa0, pa1, pa2, pa3); pv_one<2>(o[2], vb, pa0, pa1, pa2, pa3); pv_one<3>(o[3], vb, pa0, pa1, pa2, pa3);
}

DI void attn_item(const bf16_t* __restrict__ Qb, const bf16_t* __restrict__ Kh, const bf16_t* __restrict__ Vh, bf16_t* __restrict__ Ob,
                  int q0, int tile0, int ntiles, float nsl, float lam, const float* __restrict__ gsub, LAS unsigned char* lds) {
    const int tid = opaque_tid(), wid = tid >> 6, lane = tid & 63, r32 = lane & 31, hi = lane >> 5;
    const int pair = wid >> 1, cmap = wid & 1;
    Kh += (long)tile0 * 64 * LDK; Vh += (long)tile0 * 64 * LDK;
    LAS unsigned char* V_lds = lds; LAS unsigned char* K_lds = lds + 2 * SHM_V;
    LAS float* wsf = (LAS float*)(lds + 2 * SHM_V + 2 * SHM_K) + wid * 64; LAS float* li_l = wsf; LAS float* al_l = wsf + 32;
    float m_reg = -1e30f, l_reg = 0.f; f32x16 o[4]; bf16x8 qr[4];
#pragma unroll
    for (int d = 0; d < 4; ++d)
#pragma unroll
        for (int r = 0; r < 16; ++r) o[d][r] = 0.f;
    const bf16_t* Qw = Qb + (long)(pair * 32 + r32) * LDQ + cmap * 64 + hi * 8;
#pragma unroll
    for (int d0 = 0; d0 < 4; ++d0) qr[d0] = *(const bf16x8*)(Qw + d0 * 16);
    const float tq = 4.f * (float)hi - (float)(q0 + pair * 32 + r32) + (float)(tile0 * 64);
    const int sr = tid >> 4, sc = (tid & 15) * 8, vst0 = v_st(sr, sc), vst1 = v_st(32 + sr, sc);
    const int vb0 = (int)(unsigned)(size_t)V_lds + v_rd_base(lane);
    bf16x8 vs0, vs1, ks0, ks1;
#define SLOAD(k0) do { vs0 = *(const bf16x8*)(&Vh[(long)((k0) + sr) * LDK + sc]); vs1 = *(const bf16x8*)(&Vh[(long)((k0) + 32 + sr) * LDK + sc]); \
    ks0 = *(const bf16x8*)(&Kh[(long)((k0) + sr) * LDK + sc]); ks1 = *(const bf16x8*)(&Kh[(long)((k0) + 32 + sr) * LDK + sc]); } while (0)
#define SWRITE(b) do { *(LAS bf16x8*)(V_lds + (b) * SHM_V + vst0) = vs0; *(LAS bf16x8*)(V_lds + (b) * SHM_V + vst1) = vs1; const int kc = sc * 2; \
    *(LAS bf16x8*)(K_lds + (b) * SHM_K + KSWZ(sr, kc)) = ks0; *(LAS bf16x8*)(K_lds + (b) * SHM_K + KSWZ(32 + sr, kc)) = ks1; } while (0)
#define RESC(a) do { if (__any((a) < 1.f)) { if (hi == 0) al_l[r32] = (a); asm volatile("s_waitcnt lgkmcnt(0)" ::: "memory"); \
    _Pragma("unroll") for (int d = 0; d < 4; ++d) _Pragma("unroll") for (int r = 0; r < 16; ++r) o[d][r] *= al_l[crow(r, hi)]; } } while (0)
    f32x16 pA0, pA1, pB0, pB1; float mnA, mnB, alA, alB; bf16x8 pa0, pa1, pa2, pa3; const int NT = ntiles;
    const int dlo = (q0 >> 6) - tile0;
#define PSM(P0, P1, MN, AL, JR) do { const int jr_ = (JR); const float tb_ = tq + (float)(jr_ * 64); \
        if (jr_ < dlo || jr_ > dlo + 1) partialSM_lin(P0, P1, m_reg, MN, AL, tb_, jr_ < dlo ? -nsl : nsl); \
        else partialSM(P0, P1, m_reg, MN, AL, tb_, nsl); } while (0)
    SLOAD(0); SWRITE(0); __syncthreads();
    qkt(pA0, pA1, K_lds, qr, r32, hi, cmap); PSM(pA0, pA1, mnA, alA, 0);
    SLOAD(64); SWRITE(1); __syncthreads();
    for (int j = 1; j + 1 < NT; j += 2) {
        SBAR(); qkt(pB0, pB1, K_lds + SHM_K, qr, r32, hi, cmap);
        finishSM(pA0, pA1, alA, l_reg, pa0, pa1, pa2, pa3); SBAR();
        SLOAD((j + 1) * 64); SBAR();
        pv_d0(o, vb0, pa0, pa1, pa2, pa3); PSM(pB0, pB1, mnB, alB, j);
        __syncthreads(); SWRITE(0);
        RESC(alB); __syncthreads();
        SBAR(); qkt(pA0, pA1, K_lds, qr, r32, hi, cmap);
        finishSM(pB0, pB1, alB, l_reg, pa0, pa1, pa2, pa3); SBAR();
        SLOAD((j + 2) * 64); SBAR();
        pv_d0(o, vb0 + SHM_V, pa0, pa1, pa2, pa3); PSM(pA0, pA1, mnA, alA, j + 1);
        __syncthreads(); SWRITE(1);
        RESC(alA); __syncthreads();
    }
    SBAR(); qkt(pB0, pB1, K_lds + SHM_K, qr, r32, hi, cmap);
    finishSM(pA0, pA1, alA, l_reg, pa0, pa1, pa2, pa3); SBAR();
    pv_d0(o, vb0, pa0, pa1, pa2, pa3); PSM(pB0, pB1, mnB, alB, NT - 1);
    __syncthreads(); RESC(alB);
    finishSM(pB0, pB1, alB, l_reg, pa0, pa1, pa2, pa3); SBAR();
    pv_d0(o, vb0 + SHM_V, pa0, pa1, pa2, pa3);
    if (hi == 0) li_l[r32] = l_reg; asm volatile("s_waitcnt lgkmcnt(0)" ::: "memory");
    float rli[16];
    const float msc = cmap ? -lam : 1.f;
#pragma unroll
    for (int r = 0; r < 16; ++r) rli[r] = __builtin_amdgcn_rcpf(li_l[crow(r, hi)]) * msc;
    __syncthreads();
    LAS float* Obuf = (LAS float*)lds;
    if (cmap == 1) {
#pragma unroll
        for (int d0 = 0; d0 < 4; ++d0)
#pragma unroll
            for (int r = 0; r < 16; ++r) Obuf[(pair * 32 + crow(r, hi)) * 128 + d0 * 32 + r32] = o[d0][r] * rli[r];
    }
    __syncthreads();
    if (cmap == 0) {
#pragma unroll
        for (int d0 = 0; d0 < 4; ++d0)
#pragma unroll
            for (int r = 0; r < 16; ++r) Obuf[(pair * 32 + crow(r, hi)) * 128 + d0 * 32 + r32] += o[d0][r] * rli[r];
    }
    __syncthreads();
    { const int row = tid >> 2, qt = tid & 3; const LAS float* src = Obuf + row * 128 + qt * 32; float v[32]; float ss = 0.f;
#pragma unroll
      for (int j = 0; j < 8; ++j) { const f32x4 t = *(const LAS f32x4*)(src + 4 * j); v[4 * j] = t[0]; v[4 * j + 1] = t[1]; v[4 * j + 2] = t[2]; v[4 * j + 3] = t[3]; }
#pragma unroll
      for (int j = 0; j < 32; ++j) ss += v[j] * v[j];
      ss += __shfl_xor(ss, 1); ss += __shfl_xor(ss, 2);
      const float rs = rsqrtf(ss * (1.f / 128.f) + EPS) * 0.8f;
      bf16_t* dst = Ob + (long)row * 1024 + qt * 32;
#pragma unroll
      for (int j = 0; j < 4; ++j) { const f32x4 g0 = *(const f32x4*)(gsub + qt * 32 + 8 * j), g1 = *(const f32x4*)(gsub + qt * 32 + 8 * j + 4);
          u32x4 w; w.x = cvtpk(v[8 * j] * rs * g0[0], v[8 * j + 1] * rs * g0[1]); w.y = cvtpk(v[8 * j + 2] * rs * g0[2], v[8 * j + 3] * rs * g0[3]);
          w.z = cvtpk(v[8 * j + 4] * rs * g1[0], v[8 * j + 5] * rs * g1[1]); w.w = cvtpk(v[8 * j + 6] * rs * g1[2], v[8 * j + 7] * rs * g1[3]);
          *(u32x4*)(dst + 8 * j) = w; } }
    __syncthreads();
#undef SLOAD
#undef SWRITE
#undef RESC
#undef PSM
}
}

namespace rt {
constexpr int KP = 528, VP = 144, SP = 528;
constexpr int KIMG = 0, VIMG = 128 * KP, SIMG = VIMG + 128 * VP, LDS_END = SIMG + 2 * 64 * SP;
static_assert(LDS_END <= LDS_BYTES, "retention LDS");
DI s16x4 trr(LAS unsigned char* p) { return __builtin_amdgcn_ds_read_tr16_b64_v4i16((LAS s16x4*)p); }
#define CAT8(L, H) (bf16x8){L[0], L[1], L[2], L[3], H[0], H[1], H[2], H[3]}

#define LBAR() do { asm volatile("s_waitcnt lgkmcnt(0)" ::: "memory"); __builtin_amdgcn_s_barrier(); asm volatile("" ::: "memory"); } while (0)
DI void ret_item(const bf16_t* __restrict__ P, bf16_t* __restrict__ Y, int S, int h, int sl, float lgf, float lgb, LAS unsigned char* lds) {
    const int tid = opaque_tid(), wid = tid >> 6, lane = tid & 63, r = lane & 31, h2 = lane >> 5;
    const int l15 = lane & 15, quad = lane >> 4, i0 = wid * 16, db = wid;
    const int gsub = (lane >> 4) & 1, tq = l15 >> 2, tp = l15 & 3;
    const int N = S / 128;
    bf16_t* Yl = Y + h * 512 + sl * 64 + l15;
    const bf16_t* Pq = P + (long)(i0 + l15) * 4096 + h * 256 + 8 * quad;
    const bf16_t* Pk = P + (long)(tid >> 5) * 4096 + 1024 + h * 256 + (tid & 31) * 8;
    const bf16_t* Pv = P + (long)(tid >> 3) * 4096 + 2048 + h * 512 + sl * 64 + (tid & 7) * 8;
#pragma unroll 1
    for (int dir = 0; dir < 2; ++dir) {
        const float lg = dir ? lgb : lgf;
        f32x16 st0, st1;
#pragma unroll
        for (int i = 0; i < 16; ++i) { st0[i] = 0.f; st1[i] = 0.f; }
        __syncthreads();
        for (int i = tid; i < 64 * SP / 16; i += 512) *(LAS u32x4*)(lds + SIMG + i * 16) = (u32x4){0u, 0u, 0u, 0u};
        const float cd = __builtin_amdgcn_exp2f(128.f * lg);
        bf16x8 qf[8], kr[8]; u32x4 vr[2];
#define RLOAD(n_) do { const long tk = (long)(n_) * 128 * 4096; \
            _Pragma("unroll") for (int s = 0; s < 8; ++s) qf[s] = *(const bf16x8*)(Pq + tk + 32 * s); \
            _Pragma("unroll") for (int i = 0; i < 8; ++i) kr[i] = *(const bf16x8*)(Pk + tk + (long)i * 16 * 4096); \
            _Pragma("unroll") for (int i = 0; i < 2; ++i) vr[i] = *(const u32x4*)(Pv + tk + (long)i * 64 * 4096); } while (0)
        RLOAD(dir ? N - 1 : 0);
        LBAR();
#pragma unroll 1
        for (int nn = 0; nn < N; ++nn) {
            const int n = dir ? N - 1 - nn : nn;
            const long tok0 = (long)n * 128;
            const int scur = SIMG + (nn & 1) * (64 * SP), snxt = SIMG + ((nn + 1) & 1) * (64 * SP);
            f32x4 yc[4];
#pragma unroll
            for (int nb = 0; nb < 4; ++nb) yc[nb] = (f32x4){0.f, 0.f, 0.f, 0.f};
            {
                const LAS unsigned char* sb = lds + scur + l15 * SP + 16 * quad;
                bf16x8 Bc[4], Bn[4];
#pragma unroll
                for (int nb = 0; nb < 4; ++nb) Bc[nb] = *(const LAS bf16x8*)(sb + 16 * nb * SP);
#pragma unroll
                for (int s = 0; s < 8; ++s) {
                    if (s < 7) {
#pragma unroll
                        for (int nb = 0; nb < 4; ++nb) Bn[nb] = *(const LAS bf16x8*)(sb + 16 * nb * SP + 64 * (s + 1)); }
                    __builtin_amdgcn_sched_barrier(0);
#pragma unroll
                    for (int nb = 0; nb < 4; ++nb) yc[nb] = __builtin_amdgcn_mfma_f32_16x16x32_bf16(qf[s], Bc[nb], yc[nb], 0, 0, 0);
                    __builtin_amdgcn_sched_barrier(0);
#pragma unroll
                    for (int nb = 0; nb < 4; ++nb) Bc[nb] = Bn[nb];
                }
            }
#pragma unroll
            for (int jj = 0; jj < 4; ++jj) { const int i = i0 + 4 * quad + jj; const float qd = 0.0625f * __builtin_amdgcn_exp2f(lg * (float)(dir ? 128 - i : i + 1));
#pragma unroll
                for (int nb = 0; nb < 4; ++nb) yc[nb][jj] *= qd; }
#pragma unroll
            for (int i = 0; i < 8; ++i) *(LAS bf16x8*)(lds + KIMG + ((tid >> 5) + 16 * i) * KP + (tid & 31) * 16) = kr[i];
#pragma unroll
            for (int i = 0; i < 2; ++i) { const int row = (tid >> 3) + 64 * i; const u32x4 w = vr[i];
                const float kd = __builtin_amdgcn_exp2f(lg * (float)(dir ? row : 127 - row));
                u32x4 o; o.x = cvtpk(bflo(w.x) * kd, bfhi(w.x) * kd); o.y = cvtpk(bflo(w.y) * kd, bfhi(w.y) * kd);
                o.z = cvtpk(bflo(w.z) * kd, bfhi(w.z) * kd); o.w = cvtpk(bflo(w.w) * kd, bfhi(w.w) * kd);
                *(LAS u32x4*)(lds + VIMG + row * VP + (tid & 7) * 16) = o; }
            LBAR();
            if (dir == 1) {
                float yf[16];
#pragma unroll
                for (int nb = 0; nb < 4; ++nb)
#pragma unroll
                    for (int jj = 0; jj < 4; ++jj) yf[nb * 4 + jj] = bf2f(Yl[(tok0 + i0 + 4 * quad + jj) * 2048 + 16 * nb]);
                const int i = i0 + l15;
#pragma unroll 1
                for (int t = 0; t < 4; ++t) {
                    f32x4 sc0 = (f32x4){0.f, 0.f, 0.f, 0.f}, sc1 = (f32x4){0.f, 0.f, 0.f, 0.f};
#pragma unroll
                    for (int s = 0; s < 8; ++s) {
                        const bf16x8 A0 = *(const LAS bf16x8*)(lds + KIMG + (32 * t + l15) * KP + (32 * s + 8 * quad) * 2);
                        const bf16x8 A1 = *(const LAS bf16x8*)(lds + KIMG + (32 * t + 16 + l15) * KP + (32 * s + 8 * quad) * 2);
                        sc0 = __builtin_amdgcn_mfma_f32_16x16x32_bf16(A0, qf[s], sc0, 0, 0, 0);
                        sc1 = __builtin_amdgcn_mfma_f32_16x16x32_bf16(A1, qf[s], sc1, 0, 0, 0);
                        if ((s & 3) == 3) __builtin_amdgcn_sched_barrier(0); }
#pragma unroll
                    for (int jj = 0; jj < 4; ++jj) {
                        { const int j = 32 * t + 4 * quad + jj; const float a = (i > j) ? ((float)(i - j) * lgf - (float)j * lgb) : (-(float)i * lgb);
                          float w = __builtin_amdgcn_exp2f(a) * 0.0625f; if (i == j) w *= 2.f; sc0[jj] *= w; }
                        { const int j = 32 * t + 16 + 4 * quad + jj; const float a = (i > j) ? ((float)(i - j) * lgf - (float)j * lgb) : (-(float)i * lgb);
                          float w = __builtin_amdgcn_exp2f(a) * 0.0625f; if (i == j) w *= 2.f; sc1[jj] *= w; } }
                    u32x4 pw; pw.x = cvtpk(sc0[0], sc0[1]); pw.y = cvtpk(sc0[2], sc0[3]); pw.z = cvtpk(sc1[0], sc1[1]); pw.w = cvtpk(sc1[2], sc1[3]);
#pragma unroll
                    for (int nb = 0; nb < 4; ++nb) {
                        LAS unsigned char* vb = lds + VIMG + (32 * t + 4 * quad + tq) * VP + (16 * nb) * 2 + 8 * tp;
                        const s16x4 lo = trr(vb), hi = trr(vb + 16 * VP);
                        yc[nb] = __builtin_amdgcn_mfma_f32_16x16x32_bf16(__builtin_bit_cast(bf16x8, pw), CAT8(lo, hi), yc[nb], 0, 0, 0); }
                }
#pragma unroll
                for (int nb = 0; nb < 4; ++nb)
#pragma unroll
                    for (int jj = 0; jj < 4; ++jj) yc[nb][jj] += yf[nb * 4 + jj];
            }
#pragma unroll
            for (int nb = 0; nb < 4; ++nb)
#pragma unroll
                for (int jj = 0; jj < 4; ++jj) Yl[(tok0 + i0 + 4 * quad + jj) * 2048 + 16 * nb] = (bf16_t)(cvtpk(yc[nb][jj], 0.f) & 0xffffu);
            if (nn + 1 < N) RLOAD(dir ? n - 1 : n + 1);
#pragma unroll
            for (int i = 0; i < 16; ++i) { st0[i] *= cd; st1[i] *= cd; }
#pragma unroll 2
            for (int s = 0; s < 8; ++s) {
                LAS unsigned char* ka = lds + KIMG + (16 * s + 8 * h2 + tq) * KP + (db * 32 + 16 * gsub) * 2 + 8 * tp;
                LAS unsigned char* va = lds + VIMG + (16 * s + 8 * h2 + tq) * VP + (16 * gsub) * 2 + 8 * tp;
                const s16x4 alo = trr(ka), ahi = trr(ka + 4 * KP);
                const s16x4 b0lo = trr(va), b0hi = trr(va + 4 * VP), b1lo = trr(va + 64), b1hi = trr(va + 4 * VP + 64);
                const bf16x8 A = CAT8(alo, ahi);
                st0 = __builtin_amdgcn_mfma_f32_32x32x16_bf16(A, CAT8(b0lo, b0hi), st0, 0, 0, 0);
                st1 = __builtin_amdgcn_mfma_f32_32x32x16_bf16(A, CAT8(b1lo, b1hi), st1, 0, 0, 0); }
#pragma unroll
            for (int g = 0; g < 4; ++g) {
                u32x2 w0, w1; w0.x = cvtpk(st0[4 * g], st0[4 * g + 1]); w0.y = cvtpk(st0[4 * g + 2], st0[4 * g + 3]); w1.x = cvtpk(st1[4 * g], st1[4 * g + 1]); w1.y = cvtpk(st1[4 * g + 2], st1[4 * g + 3]);
                *(LAS u32x2*)(lds + snxt + r * SP + (db * 32 + 8 * g + 4 * h2) * 2) = w0;
                *(LAS u32x2*)(lds + snxt + (32 + r) * SP + (db * 32 + 8 * g + 4 * h2) * 2) = w1; }
            LBAR();
        }
#undef RLOAD
    }
    __syncthreads();
}
}

DI void grid_barrier(unsigned* ctr, unsigned gen, unsigned nblk) {
    __syncthreads();
    if (threadIdx.x == 0) {
        __builtin_amdgcn_fence(__ATOMIC_RELEASE, "agent");
        asm volatile("s_waitcnt vmcnt(0)" ::: "memory");
        unsigned* slot = ctr + 64 + 16 * (blockIdx.x & 7);
        const unsigned old = __hip_atomic_fetch_add(slot, 1u, __ATOMIC_RELAXED, __HIP_MEMORY_SCOPE_AGENT);
        if (old + 1u == gen * (nblk >> 3)) __hip_atomic_fetch_add(ctr, 1u, __ATOMIC_RELAXED, __HIP_MEMORY_SCOPE_AGENT);
        while (__hip_atomic_load(ctr, __ATOMIC_RELAXED, __HIP_MEMORY_SCOPE_AGENT) < 8u * gen) __builtin_amdgcn_s_sleep(100);
        __builtin_amdgcn_fence(__ATOMIC_ACQUIRE, "agent");
        asm volatile("s_waitcnt vmcnt(0)" ::: "memory");
    }
    __syncthreads();
}

__global__ __launch_bounds__(512, 2) void mega(Params p) {
    extern __shared__ __attribute__((aligned(16))) unsigned char shm[];
    LAS unsigned char* lds = (LAS unsigned char*)shm;
    cg::grid_group grid = cg::this_grid();
    unsigned* barctr = (unsigned*)(p.ws + WS_BAR); unsigned nbar = 0;
    const int G = gridDim.x, bid = blockIdx.x;
    const int vid = (bid & 7) * (G >> 3) + (bid >> 3);
    unsigned char* ws = p.ws;
    bf16_t* bufA = (bf16_t*)(ws + BUF_A); bf16_t* bufY = (bf16_t*)(ws + BUF_Y); bf16_t* bufBig = (bf16_t*)(ws + BUF_BIG);
    const int nph = NGROUPS * NPH;
    if (p.ph_lo < 0) grid.sync();
    for (int ph = p.ph_lo; ph < p.ph_hi && ph < nph; ++ph) {
        if (ph == 0) {
          if (PM & 1) {
            int tb = 0;
            wt_tiles(p.in[6], (bf16_t*)(ws + WT_IN0), 1024, 3072, lds, tb);
            wt_tiles(p.in[7], (bf16_t*)(ws + WT_OUT0), 1024, 1024, lds, tb);
            wt_tiles(p.in[13], (bf16_t*)(ws + WT_W10), 1024, 4096, lds, tb);
            wt_tiles(p.in[14], (bf16_t*)(ws + WT_W20), 4096, 1024, lds, tb);
            wt_tiles(p.in[19], (bf16_t*)(ws + WT_IN1), 1024, 6144, lds, tb);
            wt_tiles(p.in[20], (bf16_t*)(ws + WT_OUT1), 2048, 1024, lds, tb);
            wt_tiles(p.in[25], (bf16_t*)(ws + WT_W11), 1024, 4096, lds, tb);
            wt_tiles(p.in[26], (bf16_t*)(ws + WT_W21), 4096, 1024, lds, tb);
          }
        }
        {
            const int g = ph / NPH, s = ph % NPH;
            const float* xin = g == 0 ? p.in[0] : p.in[1];
            float* xout = p.out + (size_t)g * TG * 1024;
            const int S = g == 0 ? 2048 : 4096, BG = TG / S;
            int gk = -1; const bf16_t* gA = nullptr; const bf16_t* gB = nullptr; bf16_t* gO = nullptr; int gN = 0, gK = 0, gact = 0;
            switch (s) {
                case 0: if (bid == 0) { for (int i = threadIdx.x; i < 2048; i += 512) ((unsigned*)(ws + WS_NORM))[i] = 0u; }
                        if (PM & 2) phase_row(nullptr, xin, nullptr, bufA, nullptr, p.in[2], TG); break;
                case 1: gk = 1; gA = bufA; gB = (const bf16_t*)(ws + WT_IN0); gO = bufBig; gN = 3072; gK = 1024; break;
                case 2: phase_norms(bufBig, (unsigned*)(ws + WS_NORM), S); break;
                case 3: if (PM & 8) {
                    const int ln_ = threadIdx.x & 63;
                    const float s1 = wave_sum(p.in[8][ln_] * p.in[9][ln_]), s2 = wave_sum(p.in[10][ln_] * p.in[11][ln_]);
                    const float lam = expf(s1) - expf(s2) + 0.2f;
                    const int nQB = S / 128, nit = BG * 8 * nQB, NT = S / 64;
                    unsigned* qctr = barctr + 16 + g;
                    const unsigned* norms = (const unsigned*)(ws + WS_NORM);
                    LAS unsigned* itw = (LAS unsigned*)(lds + 67584);
                    for (;;) {
                        if (threadIdx.x == 0) *itw = __hip_atomic_fetch_add(qctr, 1u, __ATOMIC_RELAXED, __HIP_MEMORY_SCOPE_AGENT);
                        __syncthreads();
                        const int it = (int)*itw;
                        __syncthreads();
                        if (it >= nit) break;
                        const int hh = 7 - it / (BG * nQB), rem = it % (BG * nQB), b = rem / nQB, qb = rem % nQB;
                        const float msl = exp2f(-(float)(hh + 1)) * 1.4426950408889634f;
                        float W = 0.f;
#pragma unroll
                        for (int c = 0; c < 2; ++c) { const unsigned* n = norms + ((b * 8 + hh) * 2 + c) * 4;
                            const float q2 = __uint_as_float(__hip_atomic_load(n, __ATOMIC_RELAXED, __HIP_MEMORY_SCOPE_AGENT)), k2 = __uint_as_float(__hip_atomic_load(n + 1, __ATOMIC_RELAXED, __HIP_MEMORY_SCOPE_AGENT)),
                                        nz = __uint_as_float(__hip_atomic_load(n + 2, __ATOMIC_RELAXED, __HIP_MEMORY_SCOPE_AGENT));
                            W = fmaxf(W, (0.125f * 1.4426950408889634f * sqrtf(q2 * k2) * 1.001f + nz + 30.f) / msl); }
                        const int q0 = qb * 128;
                        const float lo_key = (float)q0 - W - 63.f, hi_key = (float)(q0 + 127) + W;
                        int tlo = lo_key <= 0.f ? 0 : (int)ceilf(lo_key * (1.f / 64.f)); int thi = hi_key >= (float)(S - 1) ? NT - 1 : (int)floorf(hi_key * (1.f / 64.f));
                        if (tlo > 2 * qb) tlo = 2 * qb; if (thi < 2 * qb + 1) thi = 2 * qb + 1;
                        if (((thi - tlo + 1) & 1) != 0) { if (thi < NT - 1) ++thi; else --tlo; }
                        const bf16_t* base = bufBig + (size_t)b * S * 3072;
                        da::attn_item(base + (size_t)q0 * 3072 + hh * 128, base + 1024 + hh * 128, base + 2048 + hh * 128,
                                      bufA + ((size_t)b * S + q0) * 1024 + hh * 128, q0, tlo, thi - tlo + 1, -msl, lam, p.in[12], lds);
                    }
                } break;
                case 4: gk = 1; gA = bufA; gB = (const bf16_t*)(ws + WT_OUT0); gO = bufY; gN = 1024; gK = 1024; break;
                case 5: if (PM & 2) phase_row(bufY, xin, xout, bufA, p.in[3], p.in[4], TG); break;
                case 6: gk = 1; gA = bufA; gB = (const bf16_t*)(ws + WT_W10); gO = bufBig; gN = 4096; gK = 1024; gact = 1; break;
                case 7: gk = 1; gA = bufBig; gB = (const bf16_t*)(ws + WT_W20); gO = bufA; gN = 1024; gK = 4096; break;
                case 8: if (PM & 2) phase_row(bufA, xout, xout, bufA, p.in[5], p.in[15], TG); break;
                case 9: gk = 1; gA = bufA; gB = (const bf16_t*)(ws + WT_IN1); gO = bufBig; gN = 4096; gK = 1024; break;
                case 10: if (PM & 16) {
                    const int nit = BG * 4 * 8;
                    for (int it = vid; it < nit; it += G) {
                        const int sl = it & 7, hh = (it >> 3) & 3, b = it >> 5;
                        const float lgf = log1pf(-expf(p.in[21][hh])) * 1.4426950408889634f, lgb = log1pf(-expf(p.in[22][hh])) * 1.4426950408889634f;
                        rt::ret_item(bufBig + (size_t)b * S * 4096, bufY + (size_t)b * S * 2048, S, hh, sl, lgf, lgb, lds);
                    }
                } break;
                case 11: gk = 1; gA = bufA; gB = (const bf16_t*)(ws + WT_IN1) + (size_t)4096 * 1024; gO = bufBig; gN = 2048; gK = 1024; break;
                case 12: if (PM & 32) phase_gn(bufY, bufBig, p.in[23], p.in[24], TG); break;
                case 13: gk = 1; gA = bufY; gB = (const bf16_t*)(ws + WT_OUT1); gO = bufA; gN = 1024; gK = 2048; break;
                case 14: if (PM & 2) phase_row(bufA, xout, xout, bufA, p.in[16], p.in[17], TG); break;
                case 15: gk = 1; gA = bufA; gB = (const bf16_t*)(ws + WT_W11); gO = bufBig; gN = 4096; gK = 1024; gact = 1; break;
                case 16: gk = 1; gA = bufBig; gB = (const bf16_t*)(ws + WT_W21); gO = bufA; gN = 1024; gK = 4096; break;
                case 17: if (PM & 2) phase_row(bufA, xout, xout, nullptr, p.in[18], nullptr, TG); break;
            }
            if ((PM & 4) && gk == 1) {
                pg8::Gemm gm; gm.A = gA; gm.Bt = gB; gm.M = TG; gm.N = gN; gm.K = gK;
                pg8::StaticOrder so; so.init(TG, gN, G, bid);
                pg8::EpiBf16R ep; ep.O = gO; ep.ldc = gN; ep.act = gact;
                pg8::gemm_phase<pg8::EpiBf16R, pg8::StaticOrder>(lds, gm, so, ep);
            }
        }
        if (ph + 1 < p.ph_hi && ph + 1 < nph) { ++nbar; grid_barrier(barctr, nbar, (unsigned)G); }
    }
}

extern "C" void kernel_launch(void* const* d_in, const int* in_sizes, int n_in, void* d_out, int out_size, void* d_ws, size_t ws_size, hipStream_t stream) {
    static int grid_blocks = 0;
    if (grid_blocks == 0) {
        if (n_in != 27 || ws_size < WS_END) { fprintf(stderr, "kernel_launch: unexpected n_in %d / ws_size %zu (need %zu)\n", n_in, ws_size, (size_t)WS_END); grid_blocks = -1; return; }
        int dev = 0, cus = 0, per_cu = 0;
        hipGetDevice(&dev);
        hipDeviceGetAttribute(&cus, hipDeviceAttributeMultiprocessorCount, dev);
        if (hipFuncSetAttribute((const void*)mega, hipFuncAttributeMaxDynamicSharedMemorySize, LDS_BYTES) != hipSuccess) { fprintf(stderr, "kernel_launch: hipFuncSetAttribute failed\n"); grid_blocks = -1; return; }
        hipOccupancyMaxActiveBlocksPerMultiprocessor(&per_cu, (const void*)mega, 512, LDS_BYTES);
        if (per_cu < 1) { fprintf(stderr, "kernel_launch: occupancy query says %d blocks/CU\n", per_cu); per_cu = 1; }
        grid_blocks = cus * per_cu;
        grid_blocks &= ~7;
        fprintf(stderr, "kernel_launch: grid %d (cus %d x %d)\n", grid_blocks, cus, per_cu);
    }
    if (grid_blocks < 0) return;
    Params p{};
    for (int i = 0; i < 27; ++i) p.in[i] = (const float*)d_in[i];
    p.out = (float*)d_out; p.ws = (unsigned char*)d_ws; p.ph_lo = 0; p.ph_hi = 1 << 20;
    if (hipMemsetAsync((char*)d_ws + WS_BAR, 0, 1024, stream) != hipSuccess) { fprintf(stderr, "kernel_launch: memset failed\n"); return; }
    void* args[] = {&p};
    hipError_t e = hipLaunchCooperativeKernel((const void*)mega, dim3(grid_blocks), dim3(512), args, LDS_BYTES, stream);
    if (e != hipSuccess) fprintf(stderr, "cooperative launch failed: %s (grid %d)\n", hipGetErrorString(e), grid_blocks);
}
```

```cpp
#include <hip/hip_runtime.h>
#include <hip/hip_cooperative_groups.h>
#include <cstdio>
namespace cg = cooperative_groups;

#define LAS __attribute__((address_space(3)))
#define DI __device__ __forceinline__
typedef unsigned short bf16_t;
typedef short bf16x8 __attribute__((ext_vector_type(8)));
typedef short s16x4 __attribute__((ext_vector_type(4)));
typedef float f32x4 __attribute__((ext_vector_type(4)));
typedef float f32x16 __attribute__((ext_vector_type(16)));
typedef unsigned u32x4 __attribute__((ext_vector_type(4)));
typedef unsigned u32x2 __attribute__((ext_vector_type(2)));

constexpr int TG = 65536;
constexpr int NGROUPS = 2;
constexpr int NPH = 18;
constexpr int LDS_BYTES = 153600;
constexpr float EPS = 1e-6f;
#ifndef PM
#define PM 63
#endif

constexpr size_t WT_IN0 = 0, WT_OUT0 = 6291456, WT_W10 = 8388608, WT_W20 = 16777216, WT_IN1 = 25165824, WT_OUT1 = 37748736,
                 WT_W11 = 41943040, WT_W21 = 50331648, BUF_A = 58720256, BUF_Y = 192937984, BUF_BIG = 461373440, WS_BAR = 998244352, WS_NORM = 998244352 + 1024, WS_END = 998244352 + 1024 + 8192;

struct Params {
    const float* in[27];
    float* out;
    unsigned char* ws;
    int ph_lo, ph_hi;
};

DI unsigned cvtpk(float lo, float hi) { unsigned r; asm volatile("v_cvt_pk_bf16_f32 %0, %1, %2" : "=v"(r) : "v"(lo), "v"(hi)); return r; }
DI float bf2f(unsigned short b) { return __uint_as_float(((unsigned)b) << 16); }
DI float bflo(unsigned w) { return __uint_as_float(w << 16); }
DI float bfhi(unsigned w) { return __uint_as_float(w & 0xffff0000u); }
DI float wave_sum(float v) {
#pragma unroll
    for (int o = 32; o; o >>= 1) v += __shfl_xor(v, o);
    return v;
}
DI int opaque_tid() { int t = threadIdx.x; asm volatile("" : "+v"(t)); return t; }
DI int crow(int r, int hi) { return (r & 3) + 8 * (r >> 2) + 4 * hi; }

namespace pg8 {
constexpr int BM = 256, BK = 64, HALF = 128, HTB = HALF * BK * 2, STAGE_BYTES = 8 * HTB, NXCD = 8, WGM = 8;
DI int lds_byte(int r, int c) { const int st = (r >> 4) * 2 + (c >> 5), rr = r & 15, cc = c & 31, ob = rr * 64 + cc * 2; return st * 1024 + (ob ^ (((ob >> 9) & 1) << 5)); }
DI void stage_rc(int b, int& R, int& C) { const int st = b / 1024, sb = b % 1024, swz = sb ^ (((sb >> 9) & 1) << 5); R = (st >> 1) * 16 + swz / 64; C = (st & 1) * 32 + (swz % 64) / 2; }
DI int perm32(int rho) { const int n = rho >> 4, i = rho & 15; return 8 * (i >> 2) + 4 * n + (i & 3); }
struct Unit { int pm, pn; };
struct Gemm { const bf16_t* A; const bf16_t* Bt; int M, N, K; };
struct StaticOrder {
    int nM, nN, nwg, G, c;
    DI void init(int M, int N, int G_, int c_) { nM = M / BM; nN = N / BM; nwg = nM * nN; G = G_; c = c_; }
    DI bool next(int i, Unit& u) const {
        const long L = (long)i * G + c; if (L >= nwg) return false;
        int wgid = (int)L; { const int q = nwg / NXCD, r = nwg % NXCD, xcd = wgid % NXCD, off = wgid / NXCD; wgid = (xcd < r ? xcd * (q + 1) : r * (q + 1) + (xcd - r) * q) + off; }
        const int nig = WGM * nN, gid = wgid / nig, fm = gid * WGM, gsz = (nM - fm) < WGM ? (nM - fm) : WGM;
        u.pm = fm + ((wgid % nig) % gsz); u.pn = (wgid % nig) / gsz; return true;
    }
};
struct EpiBf16R {
    static constexpr bool PERM = true;
    bf16_t* O; int ldc; int act;
    DI void operator()(const f32x4 (&acc)[2][2][4][2], const Unit& u, int wr, int wc, int fr, int fq) const {
        const int row0 = u.pm * BM + wr * 64 + fr; const int col0 = u.pn * BM + wc * 32 + 8 * fq;
#pragma unroll
        for (int ai = 0; ai < 2; ++ai)
#pragma unroll
            for (int m = 0; m < 4; ++m) { bf16_t* rowp = O + (size_t)(row0 + ai * HALF + m * 16) * ldc + col0;
#pragma unroll
                for (int bj = 0; bj < 2; ++bj) { f32x4 v0 = acc[ai][bj][m][0], v1 = acc[ai][bj][m][1];
                    if (act) {
#pragma unroll
                        for (int j = 0; j < 4; ++j) { float a = fmaxf(v0[j], 0.f), b = fmaxf(v1[j], 0.f); v0[j] = a * a; v1[j] = b * b; } }
                    u32x4 w; w.x = cvtpk(v0[0], v0[1]); w.y = cvtpk(v0[2], v0[3]); w.z = cvtpk(v1[0], v1[1]); w.w = cvtpk(v1[2], v1[3]);
                    *(u32x4*)(rowp + bj * HALF) = w; } }
    }
};

template <class Epi, class Sched>
DI void gemm_phase(LAS unsigned char* lds, const Gemm g, const Sched& S, const Epi& E) {
    const int tid = opaque_tid(), wid = __builtin_amdgcn_readfirstlane(tid >> 6), lane = tid & 63, wr = wid >> 2, wc = wid & 3, fr = lane & 15, fq = lane >> 4;
    const int K = g.K, nt = K / BK;
    unsigned voffA[2], voffB[2];
#pragma unroll
    for (int i = 0; i < 2; ++i) { int R, C; stage_rc(tid * 16 + i * 8192, R, C); const int Rb = Epi::PERM ? ((R & ~31) + perm32(R & 31)) : R;
        voffA[i] = (unsigned)(R * K + C) * 2u; voffB[i] = (unsigned)(Rb * K + C) * 2u; }
    const size_t kstep = (size_t)(BK * 2);
    const size_t hstep = (size_t)HALF * K * 2;
    const size_t tstep = 2 * hstep;
    const unsigned ldsw = (unsigned)wid * 1024u;
    const int aoff = lds_byte(wr * 64 + fr, fq * 8), boff = lds_byte(wc * 32 + fr, fq * 8);
#define PG8_SA(b, h) (((b) * 2 + (h)) * HTB)
#define PG8_SB(b, h) ((4 + (b) * 2 + (h)) * HTB)
#define PG8_STAGE(bufoff, gbase, voff) do { _Pragma("unroll") for (int _i = 0; _i < 2; ++_i) \
        __builtin_amdgcn_global_load_lds((const unsigned*)((const char*)(gbase) + (voff)[_i]), (LAS unsigned*)(lds + (bufoff) + ldsw + _i * 8192), 16, 0, 0); } while (0)
#define PG8_LDA(dst, b, h) do { _Pragma("unroll") for (int m = 0; m < 4; ++m) _Pragma("unroll") for (int k = 0; k < 2; ++k) dst[m][k] = *(const LAS bf16x8*)(lds + PG8_SA(b, h) + aoff + m * 2048 + k * 1024); } while (0)
#define PG8_LDB(dst, b, h) do { _Pragma("unroll") for (int n = 0; n < 2; ++n) _Pragma("unroll") for (int k = 0; k < 2; ++k) dst[n][k] = *(const LAS bf16x8*)(lds + PG8_SB(b, h) + boff + n * 2048 + k * 1024); } while (0)
#define PG8_MMA(ai, bj, At, Bt) do { __builtin_amdgcn_s_setprio(1); _Pragma("unroll") for (int m = 0; m < 4; ++m) _Pragma("unroll") for (int n = 0; n < 2; ++n) _Pragma("unroll") for (int k = 0; k < 2; ++k) \
        acc[ai][bj][m][n] = __builtin_amdgcn_mfma_f32_16x16x32_bf16(Bt[n][k], At[m][k], acc[ai][bj][m][n], 0, 0, 0); __builtin_amdgcn_s_setprio(0); } while (0)
#define PG8_WAIT_V(n) asm volatile("s_waitcnt vmcnt(" #n ")" ::: "memory")
#define PG8_WAIT_L(n) asm volatile("s_waitcnt lgkmcnt(" #n ")" ::: "memory")
#define PG8_BAR __builtin_amdgcn_s_barrier()
#define PG8_SCHED __builtin_amdgcn_sched_barrier(0)
    Unit cur, nxt; int ui = 0;
    if (!S.next(0, cur)) return;
    f32x4 acc[2][2][4][2];
#pragma unroll
    for (int a = 0; a < 2; ++a)
#pragma unroll
        for (int b = 0; b < 2; ++b)
#pragma unroll
            for (int m = 0; m < 4; ++m)
#pragma unroll
                for (int n = 0; n < 2; ++n) acc[a][b][m][n] = (f32x4){0.f, 0.f, 0.f, 0.f};
    bf16x8 At[4][2], B0[2][2], B1[2][2];
    const char* cA = (const char*)g.A + (size_t)cur.pm * tstep; const char* cB = (const char*)g.Bt + (size_t)cur.pn * tstep;
    PG8_STAGE(PG8_SB(0, 0), cB, voffB); PG8_STAGE(PG8_SA(0, 0), cA, voffA); PG8_STAGE(PG8_SB(0, 1), cB + hstep, voffB); PG8_STAGE(PG8_SA(0, 1), cA + hstep, voffA);
    if (wr == 1) PG8_BAR;
    PG8_WAIT_V(4); PG8_BAR;
    PG8_STAGE(PG8_SB(1, 0), cB + kstep, voffB); PG8_STAGE(PG8_SA(1, 0), cA + kstep, voffA); PG8_STAGE(PG8_SB(1, 1), cB + hstep + kstep, voffB);
    PG8_WAIT_V(6); PG8_BAR;
    for (;;) {
        const bool has_next = S.next(ui + 1, nxt);
        const char* nA = has_next ? (const char*)g.A + (size_t)nxt.pm * tstep : cA; const char* nB = has_next ? (const char*)g.Bt + (size_t)nxt.pn * tstep : cB;
        for (int t = 0; t < nt; t += 2) {
            const bool last = (t == nt - 2);
            const char* a1 = cA + (size_t)(t + 1) * kstep;
            const char* a2 = last ? nA : cA + (size_t)(t + 2) * kstep; const char* b2 = last ? nB : cB + (size_t)(t + 2) * kstep;
            const char* a3 = a2 + kstep; const char* b3 = b2 + kstep;
            PG8_LDB(B0, 0, 0); PG8_SCHED; PG8_LDA(At, 0, 0); PG8_STAGE(PG8_SA(1, 1), a1 + hstep, voffA);
            PG8_WAIT_L(8); PG8_BAR; PG8_WAIT_L(0); PG8_MMA(0, 0, At, B0); PG8_BAR; PG8_SCHED;
            PG8_LDB(B1, 0, 1); PG8_STAGE(PG8_SB(0, 0), b2, voffB);
            PG8_BAR; PG8_WAIT_L(0); PG8_MMA(0, 1, At, B1); PG8_BAR;
            PG8_LDA(At, 0, 1); PG8_STAGE(PG8_SA(0, 0), a2, voffA);
            PG8_BAR; PG8_WAIT_L(0); PG8_MMA(1, 0, At, B0); PG8_BAR; PG8_SCHED;
            PG8_STAGE(PG8_SB(0, 1), b2 + hstep, voffB);
            PG8_WAIT_V(6); PG8_BAR; PG8_MMA(1, 1, At, B1); PG8_BAR;
            PG8_LDB(B0, 1, 0); PG8_SCHED; PG8_LDA(At, 1, 0); PG8_STAGE(PG8_SA(0, 1), a2 + hstep, voffA);
            PG8_WAIT_L(8); PG8_BAR; PG8_WAIT_L(0); PG8_MMA(0, 0, At, B0); PG8_BAR; PG8_SCHED;
            PG8_LDB(B1, 1, 1); PG8_STAGE(PG8_SB(1, 0), b3, voffB);
            PG8_BAR; PG8_WAIT_L(0); PG8_MMA(0, 1, At, B1); PG8_BAR;
            PG8_LDA(At, 1, 1); PG8_STAGE(PG8_SA(1, 0), a3, voffA);
            PG8_BAR; PG8_WAIT_L(0); PG8_MMA(1, 0, At, B0); PG8_BAR; PG8_SCHED;
            PG8_STAGE(PG8_SB(1, 1), b3 + hstep, voffB);
            PG8_WAIT_V(6); PG8_BAR; PG8_MMA(1, 1, At, B1); PG8_BAR;
        }
        E(acc, cur, wr, wc, fr, fq);
        if (!has_next) break;
#pragma unroll
        for (int a = 0; a < 2; ++a)
#pragma unroll
            for (int b = 0; b < 2; ++b)
#pragma unroll
                for (int m = 0; m < 4; ++m)
#pragma unroll
                    for (int n = 0; n < 2; ++n) acc[a][b][m][n] = (f32x4){0.f, 0.f, 0.f, 0.f};
        cur = nxt; cA = nA; cB = nB; ++ui;
    }
    PG8_WAIT_V(0);
    if (wr == 0) PG8_BAR;
    PG8_BAR;
#undef PG8_SA
#undef PG8_SB
#undef PG8_STAGE
#undef PG8_LDA
#undef PG8_LDB
#undef PG8_MMA
#undef PG8_WAIT_V
#undef PG8_WAIT_L
#undef PG8_BAR
#undef PG8_SCHED
}
}

DI void wt_tiles(const float* __restrict__ W, bf16_t* __restrict__ Wt, int K, int N, LAS unsigned char* lds, int& tile_base) {
    LAS float* t = (LAS float*)lds;
    const int nk = K / 64, nn = N / 64, ntl = nk * nn, tid = opaque_tid();
    for (int tl = ((int)blockIdx.x - tile_base % (int)gridDim.x + (int)gridDim.x) % (int)gridDim.x; tl < ntl; tl += gridDim.x) {
        const int tk = tl / nn, tn = tl % nn;
        { const int kk = tid >> 3, c8 = (tid & 7) * 8; const float* src = W + (size_t)(tk * 64 + kk) * N + tn * 64 + c8;
          const f32x4 a = *(const f32x4*)src, b = *(const f32x4*)(src + 4);
          LAS float* d = t + kk * 65 + c8; d[0] = a[0]; d[1] = a[1]; d[2] = a[2]; d[3] = a[3]; d[4] = b[0]; d[5] = b[1]; d[6] = b[2]; d[7] = b[3]; }
        __syncthreads();
        { const int n = tid >> 3, k8 = (tid & 7) * 8; float v[8];
#pragma unroll
          for (int j = 0; j < 8; ++j) v[j] = t[(k8 + j) * 65 + n];
          u32x4 w; w.x = cvtpk(v[0], v[1]); w.y = cvtpk(v[2], v[3]); w.z = cvtpk(v[4], v[5]); w.w = cvtpk(v[6], v[7]);
          *(u32x4*)(Wt + (size_t)(tn * 64 + n) * K + tk * 64 + k8) = w; }
        __syncthreads();
    }
    tile_base += ntl;
}

DI void phase_row(const bf16_t* m, const float* xsrc, float* xdst, bf16_t* hn, const float* gpost, const float* gnext, int rows) {
    const int tid_ = opaque_tid(); const int lane = tid_ & 63, wid = tid_ >> 6;
    const int nw = gridDim.x * 8;
    for (int row0 = blockIdx.x * 8 + wid; row0 < rows; row0 += 2 * nw) {
        const int rws[2] = {row0, row0 + nw < rows ? row0 + nw : row0};
        float x[2][16]; u32x4 mw[2][2];
#pragma unroll
        for (int q = 0; q < 2; ++q)
#pragma unroll
            for (int c = 0; c < 2; ++c) { const float* s = xsrc + (size_t)rws[q] * 1024 + c * 512 + lane * 8; const f32x4 a = *(const f32x4*)s, b = *(const f32x4*)(s + 4);
#pragma unroll
                for (int j = 0; j < 4; ++j) { x[q][c * 8 + j] = a[j]; x[q][c * 8 + 4 + j] = b[j]; } }
        if (m) {
#pragma unroll
            for (int q = 0; q < 2; ++q)
#pragma unroll
                for (int c = 0; c < 2; ++c) mw[q][c] = *(const u32x4*)(m + (size_t)rws[q] * 1024 + c * 512 + lane * 8);
            f32x4 ga[2], gb[2];
#pragma unroll
            for (int c = 0; c < 2; ++c) { const float* gp = gpost + c * 512 + lane * 8; ga[c] = *(const f32x4*)gp; gb[c] = *(const f32x4*)(gp + 4); }
#pragma unroll
            for (int q = 0; q < 2; ++q) {
                float mv[16]; float ss = 0.f;
#pragma unroll
                for (int c = 0; c < 2; ++c)
#pragma unroll
                    for (int j = 0; j < 4; ++j) { mv[c * 8 + 2 * j] = bflo(mw[q][c][j]); mv[c * 8 + 2 * j + 1] = bfhi(mw[q][c][j]); }
#pragma unroll
                for (int j = 0; j < 16; ++j) ss += mv[j] * mv[j];
                ss = wave_sum(ss);
                const float r = rsqrtf(ss * (1.f / 1024.f) + EPS);
#pragma unroll
                for (int c = 0; c < 2; ++c)
#pragma unroll
                    for (int j = 0; j < 4; ++j) { x[q][c * 8 + j] += mv[c * 8 + j] * r * ga[c][j]; x[q][c * 8 + 4 + j] += mv[c * 8 + 4 + j] * r * gb[c][j]; }
            }
        }
        if (xdst) {
#pragma unroll
            for (int q = 0; q < 2; ++q)
#pragma unroll
                for (int c = 0; c < 2; ++c) { float* d = xdst + (size_t)rws[q] * 1024 + c * 512 + lane * 8;
                    *(f32x4*)d = (f32x4){x[q][c * 8], x[q][c * 8 + 1], x[q][c * 8 + 2], x[q][c * 8 + 3]}; *(f32x4*)(d + 4) = (f32x4){x[q][c * 8 + 4], x[q][c * 8 + 5], x[q][c * 8 + 6], x[q][c * 8 + 7]}; }
        }
        if (hn) {
            f32x4 ga[2], gb[2];
#pragma unroll
            for (int c = 0; c < 2; ++c) { const float* gp = gnext + c * 512 + lane * 8; ga[c] = *(const f32x4*)gp; gb[c] = *(const f32x4*)(gp + 4); }
#pragma unroll
            for (int q = 0; q < 2; ++q) {
                float ss = 0.f;
#pragma unroll
                for (int j = 0; j < 16; ++j) ss += x[q][j] * x[q][j];
                ss = wave_sum(ss);
                const float r = rsqrtf(ss * (1.f / 1024.f) + EPS);
#pragma unroll
                for (int c = 0; c < 2; ++c) {
                    u32x4 w; w.x = cvtpk(x[q][c * 8] * r * ga[c][0], x[q][c * 8 + 1] * r * ga[c][1]); w.y = cvtpk(x[q][c * 8 + 2] * r * ga[c][2], x[q][c * 8 + 3] * r * ga[c][3]);
                    w.z = cvtpk(x[q][c * 8 + 4] * r * gb[c][0], x[q][c * 8 + 5] * r * gb[c][1]); w.w = cvtpk(x[q][c * 8 + 6] * r * gb[c][2], x[q][c * 8 + 7] * r * gb[c][3]);
                    *(u32x4*)(hn + (size_t)rws[q] * 1024 + c * 512 + lane * 8) = w; }
            }
        }
    }
}

DI void phase_gn(bf16_t* y, const bf16_t* big, const float* gw, const float* gb, int rows) {
    const int tid_ = opaque_tid(); const int lane = tid_ & 63, wid = tid_ >> 6;
    for (int row = blockIdx.x * 8 + wid; row < rows; row += gridDim.x * 8) {
        u32x4 yw[4], gq[4];
#pragma unroll
        for (int hh = 0; hh < 4; ++hh) { yw[hh] = *(const u32x4*)(y + (size_t)row * 2048 + hh * 512 + lane * 8); gq[hh] = *(const u32x4*)(big + (size_t)row * 2048 + hh * 512 + lane * 8); }
#pragma unroll
        for (int hh = 0; hh < 4; ++hh) {
            bf16_t* yp = y + (size_t)row * 2048 + hh * 512 + lane * 8;
            float v[8], g[8];
#pragma unroll
            for (int j = 0; j < 4; ++j) { v[2 * j] = bflo(yw[hh][j]); v[2 * j + 1] = bfhi(yw[hh][j]); g[2 * j] = bflo(gq[hh][j]); g[2 * j + 1] = bfhi(gq[hh][j]); }
            float s = 0.f;
#pragma unroll
            for (int j = 0; j < 8; ++j) s += v[j];
            const float mu = wave_sum(s) * (1.f / 512.f);
            float q = 0.f;
#pragma unroll
            for (int j = 0; j < 8; ++j) { v[j] -= mu; q += v[j] * v[j]; }
            const float rs = rsqrtf(wave_sum(q) * (1.f / 512.f) + EPS);
            const float* wp = gw + hh * 512 + lane * 8; const float* bp = gb + hh * 512 + lane * 8;
            const f32x4 w0 = *(const f32x4*)wp, w1 = *(const f32x4*)(wp + 4), b0 = *(const f32x4*)bp, b1 = *(const f32x4*)(bp + 4);
            float o[8];
#pragma unroll
            for (int j = 0; j < 8; ++j) { const float wj = j < 4 ? w0[j & 3] : w1[j & 3], bj = j < 4 ? b0[j & 3] : b1[j & 3];
                const float sg = g[j] / (1.f + __expf(-g[j])); o[j] = sg * (v[j] * rs * wj + bj); }
            u32x4 ow; ow.x = cvtpk(o[0], o[1]); ow.y = cvtpk(o[2], o[3]); ow.z = cvtpk(o[4], o[5]); ow.w = cvtpk(o[6], o[7]);
            *(u32x4*)yp = ow;
        }
    }
}

DI void phase_norms(const bf16_t* __restrict__ qkv, unsigned* norms, int S) {
    const int tid = opaque_tid(), lane = tid & 63, wid = tid >> 6;
    for (int chunk = blockIdx.x * 8 + wid; chunk < TG / 32; chunk += gridDim.x * 8) {
        const int t0 = chunk * 32, b = t0 / S;
        float q2 = 0.f, k2 = 0.f, nz = 0.f;
#pragma unroll 2
        for (int t = 0; t < 32; ++t) {
            const bf16_t* row = qkv + (size_t)(t0 + t) * 3072 + lane * 16;
            const u32x4 qa = *(const u32x4*)row, qb = *(const u32x4*)(row + 8), ka = *(const u32x4*)(row + 1024), kb = *(const u32x4*)(row + 1032);
            float sq = 0.f, sk = 0.f, sd = 0.f;
#pragma unroll
            for (int j = 0; j < 4; ++j) {
                { const float a = bflo(qa[j]), c = bfhi(qa[j]), d = bflo(ka[j]), e = bfhi(ka[j]); sq += a * a + c * c; sk += d * d + e * e; sd += a * d + c * e; }
                { const float a = bflo(qb[j]), c = bfhi(qb[j]), d = bflo(kb[j]), e = bfhi(kb[j]); sq += a * a + c * c; sk += d * d + e * e; sd += a * d + c * e; } }
            sq += __shfl_xor(sq, 1); sk += __shfl_xor(sk, 1); sd += __shfl_xor(sd, 1);
            sq += __shfl_xor(sq, 2); sk += __shfl_xor(sk, 2); sd += __shfl_xor(sd, 2);
            q2 = fmaxf(q2, sq); k2 = fmaxf(k2, sk); nz = fmaxf(nz, -sd * (0.125f * 1.4426950408889634f));
        }
        if ((lane & 3) == 0) { unsigned* n = norms + ((b * 8 + (lane >> 3)) * 2 + ((lane & 7) >> 2)) * 4;
            atomicMax(n, __float_as_uint(q2)); atomicMax(n + 1, __float_as_uint(k2)); atomicMax(n + 2, __float_as_uint(nz)); }
    }
}

namespace da {
constexpr int SHM_V = 64 * 128 * 2, SHM_K = 64 * 128 * 2, LDQ = 3072, LDK = 3072;
constexpr float C = 0.125f * 1.4426950408889634f;
constexpr float THRZ = 8.f * 1.4426950408889634f;
#define KSWZ(row, colB) ((row) * 256 + ((colB) ^ (((row) & 7) << 4)))
#define SBAR() __builtin_amdgcn_sched_barrier(0)

DI void partialSM(f32x16& p0, f32x16& p1, float& m_reg, float& mn, float& alpha, float tb, float nsl) {
#pragma unroll
    for (int r = 0; r < 16; ++r) { const float t0 = tb + (float)((r & 3) + 8 * (r >> 2)); const float t1 = t0 + 32.f;
        p0[r] = fmaf(p0[r], C, nsl * fabsf(t0)); p1[r] = fmaf(p1[r], C, nsl * fabsf(t1)); }
    float pmax = p0[0];
#pragma unroll
    for (int r = 1; r < 16; ++r) pmax = fmaxf(pmax, p0[r]);
#pragma unroll
    for (int r = 0; r < 16; ++r) pmax = fmaxf(pmax, p1[r]);
    { auto rr = __builtin_amdgcn_permlane32_swap(__float_as_uint(pmax), __float_as_uint(pmax), false, false);
      pmax = fmaxf(__uint_as_float(rr[0]), __uint_as_float(rr[1])); }
    if (__builtin_expect(__all(pmax - m_reg <= THRZ), 1)) { mn = m_reg; alpha = 1.f; }
    else { mn = fmaxf(m_reg, pmax); alpha = __builtin_amdgcn_exp2f(m_reg - mn); m_reg = mn; }
#pragma unroll
    for (int r = 0; r < 16; ++r) { p0[r] -= mn; p1[r] -= mn; }
#pragma unroll
    for (int r = 0; r < 16; ++r) p0[r] = __builtin_amdgcn_exp2f(p0[r]);
}
DI void partialSM_lin(f32x16& p0, f32x16& p1, float& m_reg, float& mn, float& alpha, float tb, float sgn_nsl) {
    asm volatile("" : "+v"(sgn_nsl));
#pragma unroll
    for (int r = 0; r < 16; ++r) { const float k = sgn_nsl * (float)((r & 3) + 8 * (r >> 2)); p0[r] = fmaf(p0[r], C, k); p1[r] = fmaf(p1[r], C, k); }
    float mx0 = p0[0], mx1 = p1[0];
#pragma unroll
    for (int r = 1; r < 16; ++r) { mx0 = fmaxf(mx0, p0[r]); mx1 = fmaxf(mx1, p1[r]); }
    const float base0 = sgn_nsl * tb, base1 = base0 + 32.f * sgn_nsl;
    float pmax = fmaxf(mx0 + base0, mx1 + base1);
    { auto rr = __builtin_amdgcn_permlane32_swap(__float_as_uint(pmax), __float_as_uint(pmax), false, false);
      pmax = fmaxf(__uint_as_float(rr[0]), __uint_as_float(rr[1])); }
    if (__builtin_expect(__all(pmax - m_reg <= THRZ), 1)) { mn = m_reg; alpha = 1.f; }
    else { mn = fmaxf(m_reg, pmax); alpha = __builtin_amdgcn_exp2f(m_reg - mn); m_reg = mn; }
    const float d0 = mn - base0, d1 = mn - base1;
#pragma unroll
    for (int r = 0; r < 16; ++r) { p0[r] -= d0; p1[r] -= d1; }
#pragma unroll
    for (int r = 0; r < 16; ++r) p0[r] = __builtin_amdgcn_exp2f(p0[r]);
}
DI void finishSM(f32x16& p0, f32x16& p1, float alpha, float& l_reg, bf16x8& pa0, bf16x8& pa1, bf16x8& pa2, bf16x8& pa3) {
#pragma unroll
    for (int r = 0; r < 16; ++r) p1[r] = __builtin_amdgcn_exp2f(p1[r]);
    float ps = 0;
#pragma unroll
    for (int r = 0; r < 16; ++r) ps += p0[r];
#pragma unroll
    for (int r = 0; r < 16; ++r) ps += p1[r];
    { auto rr = __builtin_amdgcn_permlane32_swap(__float_as_uint(ps), __float_as_uint(ps), false, false);
      ps = __uint_as_float(rr[0]) + __uint_as_float(rr[1]); }
    l_reg = l_reg * alpha + ps;
#define PK4(P, BASE, OUT) do { unsigned a0 = cvtpk(P[BASE + 0], P[BASE + 1]), a1 = cvtpk(P[BASE + 2], P[BASE + 3]);   \
    unsigned b0 = cvtpk(P[BASE + 4], P[BASE + 5]), b1 = cvtpk(P[BASE + 6], P[BASE + 7]);                              \
    auto r0 = __builtin_amdgcn_permlane32_swap(a0, b0, false, false); auto r1 = __builtin_amdgcn_permlane32_swap(a1, b1, false, false); \
    u32x4 w = {r0[0], r1[0], r0[1], r1[1]}; OUT = __builtin_bit_cast(bf16x8, w); } while (0)
    PK4(p0, 0, pa0); PK4(p0, 8, pa1); PK4(p1, 0, pa2); PK4(p1, 8, pa3);
#undef PK4
}
DI void qkt(f32x16& p0, f32x16& p1, const LAS unsigned char* Ks, const bf16x8* qr, int r32, int hi, int cmap) {
#pragma unroll
    for (int r = 0; r < 16; ++r) { p0[r] = 0.f; p1[r] = 0.f; }
#pragma unroll
    for (int d0 = 0; d0 < 4; ++d0) { const int cb = (cmap * 64 + d0 * 16 + hi * 8) * 2;
        const bf16x8 b0 = *(const LAS bf16x8*)(Ks + KSWZ(r32, cb));
        const bf16x8 b1 = *(const LAS bf16x8*)(Ks + KSWZ(32 + r32, cb));
        p0 = __builtin_amdgcn_mfma_f32_32x32x16_bf16(b0, qr[d0], p0, 0, 0, 0);
        p1 = __builtin_amdgcn_mfma_f32_32x32x16_bf16(b1, qr[d0], p1, 0, 0, 0); }
}
DI int v_st(int k, int c) { const int kk = (k & ~0xC) | ((k & 4) << 1) | ((k & 8) >> 1); return ((kk >> 3) * 4 + (c >> 5)) * 512 + ((kk & 7) * 32 + (c & 31)) * 2; }
DI int v_rd_base(int lane) { return ((lane & 3) << 3) | (((lane >> 2) & 3) << 6) | (((lane >> 4) & 1) << 5) | (((lane >> 5) & 1) << 8); }
constexpr int v_rd_off(int d0, int ks, int half) { return d0 * 512 + ks * 4096 + half * 2048; }
template <int OFF> DI s16x4 tr_read(int vb) { s16x4 r; asm volatile("ds_read_b64_tr_b16 %0, %1 offset:%2" : "=&v"(r) : "v"(vb), "i"(OFF) : "memory"); return r; }
template <int D0> DI void pv_one(f32x16& od, int vb, bf16x8 pa0, bf16x8 pa1, bf16x8 pa2, bf16x8 pa3) {
    const s16x4 l0 = tr_read<v_rd_off(D0, 0, 0)>(vb), h0 = tr_read<v_rd_off(D0, 0, 1)>(vb), l1 = tr_read<v_rd_off(D0, 1, 0)>(vb), h1 = tr_read<v_rd_off(D0, 1, 1)>(vb);
    const s16x4 l2 = tr_read<v_rd_off(D0, 2, 0)>(vb), h2 = tr_read<v_rd_off(D0, 2, 1)>(vb), l3 = tr_read<v_rd_off(D0, 3, 0)>(vb), h3 = tr_read<v_rd_off(D0, 3, 1)>(vb);
    asm volatile("s_waitcnt lgkmcnt(0)" ::: "memory"); SBAR();
#define PK(L, H) (bf16x8){L[0], L[1], L[2], L[3], H[0], H[1], H[2], H[3]}
    od = __builtin_amdgcn_mfma_f32_32x32x16_bf16(pa0, PK(l0, h0), od, 0, 0, 0);
    od = __builtin_amdgcn_mfma_f32_32x32x16_bf16(pa1, PK(l1, h1), od, 0, 0, 0);
    od = __builtin_amdgcn_mfma_f32_32x32x16_bf16(pa2, PK(l2, h2), od, 0, 0, 0);
    od = __builtin_amdgcn_mfma_f32_32x32x16_bf16(pa3, PK(l3, h3), od, 0, 0, 0);
#undef PK
}
DI void pv_d0(f32x16* o, int vb, bf16x8 pa0, bf16x8 pa1, bf16x8 pa2, bf16x8 pa3) {
    pv_one<0>(o[0], vb, pa0, pa1, pa2, pa3); pv_one<1>(o[1], vb, pa0, pa1, pa2, pa3); pv_one<2>(o[2], vb, pa0, pa1, pa2, pa3); pv_one<3>(o[3], vb, pa0, pa1, pa2, pa3);
}

DI void attn_item(const bf16_t* __restrict__ Qb, const bf16_t* __restrict__ Kh, const bf16_t* __restrict__ Vh, bf16_t* __restrict__ Ob,
                  int q0, int tile0, int ntiles, float nsl, float lam, const float* __restrict__ gsub, LAS unsigned char* lds) {
    const int tid = opaque_tid(), wid = tid >> 6, lane = tid & 63, r32 = lane & 31, hi = lane >> 5;
    const int pair = wid >> 1, cmap = wid & 1;
    Kh += (long)tile0 * 64 * LDK; Vh += (long)tile0 * 64 * LDK;
    LAS unsigned char* V_lds = lds; LAS unsigned char* K_lds = lds + 2 * SHM_V;
    LAS float* wsf = (LAS float*)(lds + 2 * SHM_V + 2 * SHM_K) + wid * 64; LAS float* li_l = wsf; LAS float* al_l = wsf + 32;
    float m_reg = -1e30f, l_reg = 0.f; f32x16 o[4]; bf16x8 qr[4];
#pragma unroll
    for (int d = 0; d < 4; ++d)
#pragma unroll
        for (int r = 0; r < 16; ++r) o[d][r] = 0.f;
    const bf16_t* Qw = Qb + (long)(pair * 32 + r32) * LDQ + cmap * 64 + hi * 8;
#pragma unroll
    for (int d0 = 0; d0 < 4; ++d0) qr[d0] = *(const bf16x8*)(Qw + d0 * 16);
    const float tq = 4.f * (float)hi - (float)(q0 + pair * 32 + r32) + (float)(tile0 * 64);
    const int sr = tid >> 4, sc = (tid & 15) * 8, vst0 = v_st(sr, sc), vst1 = v_st(32 + sr, sc);
    const int vb0 = (int)(unsigned)(size_t)V_lds + v_rd_base(lane);
    bf16x8 vs0, vs1, ks0, ks1;
#define SLOAD(k0) do { vs0 = *(const bf16x8*)(&Vh[(long)((k0) + sr) * LDK + sc]); vs1 = *(const bf16x8*)(&Vh[(long)((k0) + 32 + sr) * LDK + sc]); \
    ks0 = *(const bf16x8*)(&Kh[(long)((k0) + sr) * LDK + sc]); ks1 = *(const bf16x8*)(&Kh[(long)((k0) + 32 + sr) * LDK + sc]); } while (0)
#define SWRITE(b) do { *(LAS bf16x8*)(V_lds + (b) * SHM_V + vst0) = vs0; *(LAS bf16x8*)(V_lds + (b) * SHM_V + vst1) = vs1; const int kc = sc * 2; \
    *(LAS bf16x8*)(K_lds + (b) * SHM_K + KSWZ(sr, kc)) = ks0; *(LAS bf16x8*)(K_lds + (b) * SHM_K + KSWZ(32 + sr, kc)) = ks1; } while (0)
#define RESC(a) do { if (__any((a) < 1.f)) { if (hi == 0) al_l[r32] = (a); asm volatile("s_waitcnt lgkmcnt(0)" ::: "memory"); \
    _Pragma("unroll") for (int d = 0; d < 4; ++d) _Pragma("unroll") for (int r = 0; r < 16; ++r) o[d][r] *= al_l[crow(r, hi)]; } } while (0)
    f32x16 pA0, pA1, pB0, pB1; float mnA, mnB, alA, alB; bf16x8 pa0, pa1, pa2, pa3; const int NT = ntiles;
    const int dlo = (q0 >> 6) - tile0;
#define PSM(P0, P1, MN, AL, JR) do { const int jr_ = (JR); const float tb_ = tq + (float)(jr_ * 64); \
        if (jr_ < dlo || jr_ > dlo + 1) partialSM_lin(P0, P1, m_reg, MN, AL, tb_, jr_ < dlo ? -nsl : nsl); \
        else partialSM(P0, P1, m_reg, MN, AL, tb_, nsl); } while (0)
    SLOAD(0); SWRITE(0); __syncthreads();
    qkt(pA0, pA1, K_lds, qr, r32, hi, cmap); PSM(pA0, pA1, mnA, alA, 0);
    SLOAD(64); SWRITE(1); __syncthreads();
    for (int j = 1; j + 1 < NT; j += 2) {
        SBAR(); qkt(pB0, pB1, K_lds + SHM_K, qr, r32, hi, cmap);
        finishSM(pA0, pA1, alA, l_reg, pa0, pa1, pa2, pa3); SBAR();
        SLOAD((j + 1) * 64); SBAR();
        pv_d0(o, vb0, pa0, pa1, pa2, pa3); PSM(pB0, pB1, mnB, alB, j);
        __syncthreads(); SWRITE(0);
        RESC(alB); __syncthreads();
        SBAR(); qkt(pA0, pA1, K_lds, qr, r32, hi, cmap);
        finishSM(pB0, pB1, alB, l_reg, pa0, pa1, pa2, pa3); SBAR();
        SLOAD((j + 2) * 64); SBAR();
        pv_d0(o, vb0 + SHM_V, pa0, pa1, pa2, pa3); PSM(pA0, pA1, mnA, alA, j + 1);
        __syncthreads(); SWRITE(1);
        RESC(alA); __syncthreads();
    }
    SBAR(); qkt(pB0, pB1, K_lds + SHM_K, qr, r32, hi, cmap);
    finishSM(pA0, pA1, alA, l_reg, pa0, pa1, pa2, pa3); SBAR();
    pv_d0(o, vb0, pa0, pa1, pa2, pa3); PSM(pB0, pB1, mnB, alB, NT - 1);
    __syncthreads(); RESC(alB);
    finishSM(pB0, pB1, alB, l_reg, pa0, pa1, pa2, pa3); SBAR();
    pv_d0(o, vb0 + SHM_V, pa0, pa1, pa2, pa3);
    if (hi == 0) li_l[r32] = l_reg; asm volatile("s_waitcnt lgkmcnt(0)" ::: "memory");
    float rli[16];
    const float msc = cmap ? -lam : 1.f;
#pragma unroll
    for (int r = 0; r < 16; ++r) rli[r] = __builtin_amdgcn_rcpf(li_l[crow(r, hi)]) * msc;
    __syncthreads();
    LAS float* Obuf = (LAS float*)lds;
    if (cmap == 1) {
#pragma unroll
        for (int d0 = 0; d0 < 4; ++d0)
#pragma unroll
            for (int r = 0; r < 16; ++r) Obuf[(pair * 32 + crow(r, hi)) * 128 + d0 * 32 + r32] = o[d0][r] * rli[r];
    }
    __syncthreads();
    if (cmap == 0) {
#pragma unroll
        for (int d0 = 0; d0 < 4; ++d0)
#pragma unroll
            for (int r = 0; r < 16; ++r) Obuf[(pair * 32 + crow(r, hi)) * 128 + d0 * 32 + r32] += o[d0][r] * rli[r];
    }
    __syncthreads();
    { const int row = tid >> 2, qt = tid & 3; const LAS float* src = Obuf + row * 128 + qt * 32; float v[32]; float ss = 0.f;
#pragma unroll
      for (int j = 0; j < 8; ++j) { const f32x4 t = *(const LAS f32x4*)(src + 4 * j); v[4 * j] = t[0]; v[4 * j + 1] = t[1]; v[4 * j + 2] = t[2]; v[4 * j + 3] = t[3]; }
#pragma unroll
      for (int j = 0; j < 32; ++j) ss += v[j] * v[j];
      ss += __shfl_xor(ss, 1); ss += __shfl_xor(ss, 2);
      const float rs = rsqrtf(ss * (1.f / 128.f) + EPS) * 0.8f;
      bf16_t* dst = Ob + (long)row * 1024 + qt * 32;
#pragma unroll
      for (int j = 0; j < 4; ++j) { const f32x4 g0 = *(const f32x4*)(gsub + qt * 32 + 8 * j), g1 = *(const f32x4*)(gsub + qt * 32 + 8 * j + 4);
          u32x4 w; w.x = cvtpk(v[8 * j] * rs * g0[0], v[8 * j + 1] * rs * g0[1]); w.y = cvtpk(v[8 * j + 2] * rs * g0[2], v[8 * j + 3] * rs * g0[3]);
          w.z = cvtpk(v[8 * j + 4] * rs * g1[0], v[8 * j + 5] * rs * g1[1]); w.w = cvtpk(v[8 * j + 6] * rs * g1[2], v[8 * j + 7] * rs * g1[3]);
          *(u32x4*)(dst + 8 * j) = w; } }
    __syncthreads();
#undef SLOAD
#undef SWRITE
#undef RESC
#undef PSM
}
}

namespace rt {
constexpr int KP = 528, VP = 144, SP = 528;
constexpr int KIMG = 0, VIMG = 128 * KP, SIMG = VIMG + 128 * VP, LDS_END = SIMG + 2 * 64 * SP;
static_assert(LDS_END <= LDS_BYTES, "retention LDS");
DI s16x4 trr(LAS unsigned char* p) { return __builtin_amdgcn_ds_read_tr16_b64_v4i16((LAS s16x4*)p); }
#define CAT8(L, H) (bf16x8){L[0], L[1], L[2], L[3], H[0], H[1], H[2], H[3]}

#define LBAR() do { asm volatile("s_waitcnt lgkmcnt(0)" ::: "memory"); __builtin_amdgcn_s_barrier(); asm volatile("" ::: "memory"); } while (0)
DI void ret_item(const bf16_t* __restrict__ P, bf16_t* __restrict__ Y, int S, int h, int sl, float lgf, float lgb, LAS unsigned char* lds) {
    const int tid = opaque_tid(), wid = tid >> 6, lane = tid & 63, r = lane & 31, h2 = lane >> 5;
    const int l15 = lane & 15, quad = lane >> 4, i0 = wid * 16, db = wid;
    const int gsub = (lane >> 4) & 1, tq = l15 >> 2, tp = l15 & 3;
    const int N = S / 128;
    bf16_t* Yl = Y + h * 512 + sl * 64 + l15;
    const bf16_t* Pq = P + (long)(i0 + l15) * 4096 + h * 256 + 8 * quad;
    const bf16_t* Pk = P + (long)(tid >> 5) * 4096 + 1024 + h * 256 + (tid & 31) * 8;
    const bf16_t* Pv = P + (long)(tid >> 3) * 4096 + 2048 + h * 512 + sl * 64 + (tid & 7) * 8;
#pragma unroll 1
    for (int dir = 0; dir < 2; ++dir) {
        const float lg = dir ? lgb : lgf;
        f32x16 st0, st1;
#pragma unroll
        for (int i = 0; i < 16; ++i) { st0[i] = 0.f; st1[i] = 0.f; }
        __syncthreads();
        for (int i = tid; i < 64 * SP / 16; i += 512) *(LAS u32x4*)(lds + SIMG + i * 16) = (u32x4){0u, 0u, 0u, 0u};
        const float cd = __builtin_amdgcn_exp2f(128.f * lg);
        bf16x8 qf[8], kr[8]; u32x4 vr[2];
#define RLOAD(n_) do { const long tk = (long)(n_) * 128 * 4096; \
            _Pragma("unroll") for (int s = 0; s < 8; ++s) qf[s] = *(const bf16x8*)(Pq + tk + 32 * s); \
            _Pragma("unroll") for (int i = 0; i < 8; ++i) kr[i] = *(const bf16x8*)(Pk + tk + (long)i * 16 * 4096); \
            _Pragma("unroll") for (int i = 0; i < 2; ++i) vr[i] = *(const u32x4*)(Pv + tk + (long)i * 64 * 4096); } while (0)
        RLOAD(dir ? N - 1 : 0);
        LBAR();
#pragma unroll 1
        for (int nn = 0; nn < N; ++nn) {
            const int n = dir ? N - 1 - nn : nn;
            const long tok0 = (long)n * 128;
            const int scur = SIMG + (nn & 1) * (64 * SP), snxt = SIMG + ((nn + 1) & 1) * (64 * SP);
            f32x4 yc[4];
#pragma unroll
            for (int nb = 0; nb < 4; ++nb) yc[nb] = (f32x4){0.f, 0.f, 0.f, 0.f};
            {
                const LAS unsigned char* sb = lds + scur + l15 * SP + 16 * quad;
                bf16x8 Bc[4], Bn[4];
#pragma unroll
                for (int nb = 0; nb < 4; ++nb) Bc[nb] = *(const LAS bf16x8*)(sb + 16 * nb * SP);
#pragma unroll
                for (int s = 0; s < 8; ++s) {
                    if (s < 7) {
#pragma unroll
                        for (int nb = 0; nb < 4; ++nb) Bn[nb] = *(const LAS bf16x8*)(sb + 16 * nb * SP + 64 * (s + 1)); }
                    __builtin_amdgcn_sched_barrier(0);
#pragma unroll
                    for (int nb = 0; nb < 4; ++nb) yc[nb] = __builtin_amdgcn_mfma_f32_16x16x32_bf16(qf[s], Bc[nb], yc[nb], 0, 0, 0);
                    __builtin_amdgcn_sched_barrier(0);
#pragma unroll
                    for (int nb = 0; nb < 4; ++nb) Bc[nb] = Bn[nb];
                }
            }
#pragma unroll
            for (int jj = 0; jj < 4; ++jj) { const int i = i0 + 4 * quad + jj; const float qd = 0.0625f * __builtin_amdgcn_exp2f(lg * (float)(dir ? 128 - i : i + 1));
#pragma unroll
                for (int nb = 0; nb < 4; ++nb) yc[nb][jj] *= qd; }
#pragma unroll
            for (int i = 0; i < 8; ++i) *(LAS bf16x8*)(lds + KIMG + ((tid >> 5) + 16 * i) * KP + (tid & 31) * 16) = kr[i];
#pragma unroll
            for (int i = 0; i < 2; ++i) { const int row = (tid >> 3) + 64 * i; const u32x4 w = vr[i];
                const float kd = __builtin_amdgcn_exp2f(lg * (float)(dir ? row : 127 - row));
                u32x4 o; o.x = cvtpk(bflo(w.x) * kd, bfhi(w.x) * kd); o.y = cvtpk(bflo(w.y) * kd, bfhi(w.y) * kd);
                o.z = cvtpk(bflo(w.z) * kd, bfhi(w.z) * kd); o.w = cvtpk(bflo(w.w) * kd, bfhi(w.w) * kd);
                *(LAS u32x4*)(lds + VIMG + row * VP + (tid & 7) * 16) = o; }
            LBAR();
            if (dir == 1) {
                float yf[16];
#pragma unroll
                for (int nb = 0; nb < 4; ++nb)
#pragma unroll
                    for (int jj = 0; jj < 4; ++jj) yf[nb * 4 + jj] = bf2f(Yl[(tok0 + i0 + 4 * quad + jj) * 2048 + 16 * nb]);
                const int i = i0 + l15;
#pragma unroll 1
                for (int t = 0; t < 4; ++t) {
                    f32x4 sc0 = (f32x4){0.f, 0.f, 0.f, 0.f}, sc1 = (f32x4){0.f, 0.f, 0.f, 0.f};
#pragma unroll
                    for (int s = 0; s < 8; ++s) {
                        const bf16x8 A0 = *(const LAS bf16x8*)(lds + KIMG + (32 * t + l15) * KP + (32 * s + 8 * quad) * 2);
                        const bf16x8 A1 = *(const LAS bf16x8*)(lds + KIMG + (32 * t + 16 + l15) * KP + (32 * s + 8 * quad) * 2);
                        sc0 = __builtin_amdgcn_mfma_f32_16x16x32_bf16(A0, qf[s], sc0, 0, 0, 0);
                        sc1 = __builtin_amdgcn_mfma_f32_16x16x32_bf16(A1, qf[s], sc1, 0, 0, 0);
                        if ((s & 3) == 3) __builtin_amdgcn_sched_barrier(0); }
#pragma unroll
                    for (int jj = 0; jj < 4; ++jj) {
                        { const int j = 32 * t + 4 * quad + jj; const float a = (i > j) ? ((float)(i - j) * lgf - (float)j * lgb) : (-(float)i * lgb);
                          float w = __builtin_amdgcn_exp2f(a) * 0.0625f; if (i == j) w *= 2.f; sc0[jj] *= w; }
                        { const int j = 32 * t + 16 + 4 * quad + jj; const float a = (i > j) ? ((float)(i - j) * lgf - (float)j * lgb) : (-(float)i * lgb);
                          float w = __builtin_amdgcn_exp2f(a) * 0.0625f; if (i == j) w *= 2.f; sc1[jj] *= w; } }
                    u32x4 pw; pw.x = cvtpk(sc0[0], sc0[1]); pw.y = cvtpk(sc0[2], sc0[3]); pw.z = cvtpk(sc1[0], sc1[1]); pw.w = cvtpk(sc1[2], sc1[3]);
#pragma unroll
                    for (int nb = 0; nb < 4; ++nb) {
                        LAS unsigned char* vb = lds + VIMG + (32 * t + 4 * quad + tq) * VP + (16 * nb) * 2 + 8 * tp;
                        const s16x4 lo = trr(vb), hi = trr(vb + 16 * VP);
                        yc[nb] = __builtin_amdgcn_mfma_f32_16x16x32_bf16(__builtin_bit_cast(bf16x8, pw), CAT8(lo, hi), yc[nb], 0, 0, 0); }
                }
#pragma unroll
                for (int nb = 0; nb < 4; ++nb)
#pragma unroll
                    for (int jj = 0; jj < 4; ++jj) yc[nb][jj] += yf[nb * 4 + jj];
            }
#pragma unroll
            for (int nb = 0; nb < 4; ++nb)
#pragma unroll
                for (int jj = 0; jj < 4; ++jj) Yl[(tok0 + i0 + 4 * quad + jj) * 2048 + 16 * nb] = (bf16_t)(cvtpk(yc[nb][jj], 0.f) & 0xffffu);
            if (nn + 1 < N) RLOAD(dir ? n - 1 : n + 1);
#pragma unroll
            for (int i = 0; i < 16; ++i) { st0[i] *= cd; st1[i] *= cd; }
#pragma unroll 2
            for (int s = 0; s < 8; ++s) {
                LAS unsigned char* ka = lds + KIMG + (16 * s + 8 * h2 + tq) * KP + (db * 32 + 16 * gsub) * 2 + 8 * tp;
                LAS unsigned char* va = lds + VIMG + (16 * s + 8 * h2 + tq) * VP + (16 * gsub) * 2 + 8 * tp;
                const s16x4 alo = trr(ka), ahi = trr(ka + 4 * KP);
                const s16x4 b0lo = trr(va), b0hi = trr(va + 4 * VP), b1lo = trr(va + 64), b1hi = trr(va + 4 * VP + 64);
                const bf16x8 A = CAT8(alo, ahi);
                st0 = __builtin_amdgcn_mfma_f32_32x32x16_bf16(A, CAT8(b0lo, b0hi), st0, 0, 0, 0);
                st1 = __builtin_amdgcn_mfma_f32_32x32x16_bf16(A, CAT8(b1lo, b1hi), st1, 0, 0, 0); }
#pragma unroll
            for (int g = 0; g < 4; ++g) {
                u32x2 w0, w1; w0.x = cvtpk(st0[4 * g], st0[4 * g + 1]); w0.y = cvtpk(st0[4 * g + 2], st0[4 * g + 3]); w1.x = cvtpk(st1[4 * g], st1[4 * g + 1]); w1.y = cvtpk(st1[4 * g + 2], st1[4 * g + 3]);
                *(LAS u32x2*)(lds + snxt + r * SP + (db * 32 + 8 * g + 4 * h2) * 2) = w0;
                *(LAS u32x2*)(lds + snxt + (32 + r) * SP + (db * 32 + 8 * g + 4 * h2) * 2) = w1; }
            LBAR();
        }
#undef RLOAD
    }
    __syncthreads();
}
}

DI void grid_barrier(unsigned* ctr, unsigned gen, unsigned nblk) {
    __syncthreads();
    if (threadIdx.x == 0) {
        __builtin_amdgcn_fence(__ATOMIC_RELEASE, "agent");
        asm volatile("s_waitcnt vmcnt(0)" ::: "memory");
        unsigned* slot = ctr + 64 + 16 * (blockIdx.x & 7);
        const unsigned old = __hip_atomic_fetch_add(slot, 1u, __ATOMIC_RELAXED, __HIP_MEMORY_SCOPE_AGENT);
        if (old + 1u == gen * (nblk >> 3)) __hip_atomic_fetch_add(ctr, 1u, __ATOMIC_RELAXED, __HIP_MEMORY_SCOPE_AGENT);
        while (__hip_atomic_load(ctr, __ATOMIC_RELAXED, __HIP_MEMORY_SCOPE_AGENT) < 8u * gen) __builtin_amdgcn_s_sleep(100);
        __builtin_amdgcn_fence(__ATOMIC_ACQUIRE, "agent");
        asm volatile("s_waitcnt vmcnt(0)" ::: "memory");
    }
    __syncthreads();
}

__global__ __launch_bounds__(512, 2) void mega(Params p) {
    extern __shared__ __attribute__((aligned(16))) unsigned char shm[];
    LAS unsigned char* lds = (LAS unsigned char*)shm;
    cg::grid_group grid = cg::this_grid();
    unsigned* barctr = (unsigned*)(p.ws + WS_BAR); unsigned nbar = 0;
    const int G = gridDim.x, bid = blockIdx.x;
    const int vid = (bid & 7) * (G >> 3) + (bid >> 3);
    unsigned char* ws = p.ws;
    bf16_t* bufA = (bf16_t*)(ws + BUF_A); bf16_t* bufY = (bf16_t*)(ws + BUF_Y); bf16_t* bufBig = (bf16_t*)(ws + BUF_BIG);
    const int nph = NGROUPS * NPH;
    if (p.ph_lo < 0) grid.sync();
    for (int ph = p.ph_lo; ph < p.ph_hi && ph < nph; ++ph) {
        if (ph == 0) {
          if (PM & 1) {
            int tb = 0;
            wt_tiles(p.in[6], (bf16_t*)(ws + WT_IN0), 1024, 3072, lds, tb);
            wt_tiles(p.in[7], (bf16_t*)(ws + WT_OUT0), 1024, 1024, lds, tb);
            wt_tiles(p.in[13], (bf16_t*)(ws + WT_W10), 1024, 4096, lds, tb);
            wt_tiles(p.in[14], (bf16_t*)(ws + WT_W20), 4096, 1024, lds, tb);
            wt_tiles(p.in[19], (bf16_t*)(ws + WT_IN1), 1024, 6144, lds, tb);
            wt_tiles(p.in[20], (bf16_t*)(ws + WT_OUT1), 2048, 1024, lds, tb);
            wt_tiles(p.in[25], (bf16_t*)(ws + WT_W11), 1024, 4096, lds, tb);
            wt_tiles(p.in[26], (bf16_t*)(ws + WT_W21), 4096, 1024, lds, tb);
          }
        }
        {
            const int g = ph / NPH, s = ph % NPH;
            const float* xin = g == 0 ? p.in[0] : p.in[1];
            float* xout = p.out + (size_t)g * TG * 1024;
            const int S = g == 0 ? 2048 : 4096, BG = TG / S;
            int gk = -1; const bf16_t* gA = nullptr; const bf16_t* gB = nullptr; bf16_t* gO = nullptr; int gN = 0, gK = 0, gact = 0;
            switch (s) {
                case 0: if (bid == 0) { for (int i = threadIdx.x; i < 2048; i += 512) ((unsigned*)(ws + WS_NORM))[i] = 0u; }
                        if (PM & 2) phase_row(nullptr, xin, nullptr, bufA, nullptr, p.in[2], TG); break;
                case 1: gk = 1; gA = bufA; gB = (const bf16_t*)(ws + WT_IN0); gO = bufBig; gN = 3072; gK = 1024; break;
                case 2: phase_norms(bufBig, (unsigned*)(ws + WS_NORM), S); break;
                case 3: if (PM & 8) {
                    const int ln_ = threadIdx.x & 63;
                    const float s1 = wave_sum(p.in[8][ln_] * p.in[9][ln_]), s2 = wave_sum(p.in[10][ln_] * p.in[11][ln_]);
                    const float lam = expf(s1) - expf(s2) + 0.2f;
                    const int nQB = S / 128, nit = BG * 8 * nQB, NT = S / 64;
                    unsigned* qctr = barctr + 16 + g;
                    const unsigned* norms = (const unsigned*)(ws + WS_NORM);
                    LAS unsigned* itw = (LAS unsigned*)(lds + 67584);
                    LAS float* wtab = (LAS float*)(lds + 67584 + 64);
#pragma unroll 1
                    for (int e = opaque_tid(); e < BG * 8; e += 512) {
                        const int hh_ = e & 7; const float msl_ = exp2f(-(float)(hh_ + 1)) * 1.4426950408889634f;
                        float W_ = 0.f;
#pragma unroll
                        for (int c = 0; c < 2; ++c) { const unsigned* n = norms + (e * 2 + c) * 4;
                            const float q2 = __uint_as_float(__hip_atomic_load(n, __ATOMIC_RELAXED, __HIP_MEMORY_SCOPE_AGENT)), k2 = __uint_as_float(__hip_atomic_load(n + 1, __ATOMIC_RELAXED, __HIP_MEMORY_SCOPE_AGENT)),
                                        nz = __uint_as_float(__hip_atomic_load(n + 2, __ATOMIC_RELAXED, __HIP_MEMORY_SCOPE_AGENT));
                            W_ = fmaxf(W_, (0.125f * 1.4426950408889634f * sqrtf(q2 * k2) * 1.001f + nz + 30.f) / msl_); }
                        wtab[e] = W_; }
                    __syncthreads();
                    for (;;) {
                        if (threadIdx.x == 0) *itw = __hip_atomic_fetch_add(qctr, 1u, __ATOMIC_RELAXED, __HIP_MEMORY_SCOPE_AGENT);
                        __syncthreads();
                        const int it = (int)*itw;
                        __syncthreads();
                        if (it >= nit) break;
                        const int hh = 7 - it / (BG * nQB), rem = it % (BG * nQB), b = rem / nQB, qb = rem % nQB;
                        const float msl = exp2f(-(float)(hh + 1)) * 1.4426950408889634f;
                        const float W = wtab[b * 8 + hh];
                        const int q0 = qb * 128;
                        const float lo_key = (float)q0 - W - 63.f, hi_key = (float)(q0 + 127) + W;
                        int tlo = lo_key <= 0.f ? 0 : (int)ceilf(lo_key * (1.f / 64.f)); int thi = hi_key >= (float)(S - 1) ? NT - 1 : (int)floorf(hi_key * (1.f / 64.f));
                        if (tlo > 2 * qb) tlo = 2 * qb; if (thi < 2 * qb + 1) thi = 2 * qb + 1;
                        if (((thi - tlo + 1) & 1) != 0) { if (thi < NT - 1) ++thi; else --tlo; }
                        const bf16_t* base = bufBig + (size_t)b * S * 3072;
                        da::attn_item(base + (size_t)q0 * 3072 + hh * 128, base + 1024 + hh * 128, base + 2048 + hh * 128,
                                      bufA + ((size_t)b * S + q0) * 1024 + hh * 128, q0, tlo, thi - tlo + 1, -msl, lam, p.in[12], lds);
                    }
                } break;
                case 4: gk = 1; gA = bufA; gB = (const bf16_t*)(ws + WT_OUT0); gO = bufY; gN = 1024; gK = 1024; break;
                case 5: if (PM & 2) phase_row(bufY, xin, xout, bufA, p.in[3], p.in[4], TG); break;
                case 6: gk = 1; gA = bufA; gB = (const bf16_t*)(ws + WT_W10); gO = bufBig; gN = 4096; gK = 1024; gact = 1; break;
                case 7: gk = 1; gA = bufBig; gB = (const bf16_t*)(ws + WT_W20); gO = bufA; gN = 1024; gK = 4096; break;
                case 8: if (PM & 2) phase_row(bufA, xout, xout, bufA, p.in[5], p.in[15], TG); break;
                case 9: gk = 1; gA = bufA; gB = (const bf16_t*)(ws + WT_IN1); gO = bufBig; gN = 4096; gK = 1024; break;
                case 10: if (PM & 16) {
                    const int nit = BG * 4 * 8;
                    for (int it = vid; it < nit; it += G) {
                        const int sl = it & 7, hh = (it >> 3) & 3, b = it >> 5;
                        const float lgf = log1pf(-expf(p.in[21][hh])) * 1.4426950408889634f, lgb = log1pf(-expf(p.in[22][hh])) * 1.4426950408889634f;
                        rt::ret_item(bufBig + (size_t)b * S * 4096, bufY + (size_t)b * S * 2048, S, hh, sl, lgf, lgb, lds);
                    }
                } break;
                case 11: gk = 1; gA = bufA; gB = (const bf16_t*)(ws + WT_IN1) + (size_t)4096 * 1024; gO = bufBig; gN = 2048; gK = 1024; break;
                case 12: if (PM & 32) phase_gn(bufY, bufBig, p.in[23], p.in[24], TG); break;
                case 13: gk = 1; gA = bufY; gB = (const bf16_t*)(ws + WT_OUT1); gO = bufA; gN = 1024; gK = 2048; break;
                case 14: if (PM & 2) phase_row(bufA, xout, xout, bufA, p.in[16], p.in[17], TG); break;
                case 15: gk = 1; gA = bufA; gB = (const bf16_t*)(ws + WT_W11); gO = bufBig; gN = 4096; gK = 1024; gact = 1; break;
                case 16: gk = 1; gA = bufBig; gB = (const bf16_t*)(ws + WT_W21); gO = bufA; gN = 1024; gK = 4096; break;
                case 17: if (PM & 2) phase_row(bufA, xout, xout, nullptr, p.in[18], nullptr, TG); break;
            }
            if ((PM & 4) && gk == 1) {
                pg8::Gemm gm; gm.A = gA; gm.Bt = gB; gm.M = TG; gm.N = gN; gm.K = gK;
                pg8::StaticOrder so; so.init(TG, gN, G, bid);
                pg8::EpiBf16R ep; ep.O = gO; ep.ldc = gN; ep.act = gact;
                pg8::gemm_phase<pg8::EpiBf16R, pg8::StaticOrder>(lds, gm, so, ep);
            }
        }
        if (ph + 1 < p.ph_hi && ph + 1 < nph) { ++nbar; grid_barrier(barctr, nbar, (unsigned)G); }
    }
}

extern "C" void kernel_launch(void* const* d_in, const int* in_sizes, int n_in, void* d_out, int out_size, void* d_ws, size_t ws_size, hipStream_t stream) {
    static int grid_blocks = 0;
    if (grid_blocks == 0) {
        if (n_in != 27 || ws_size < WS_END) { fprintf(stderr, "kernel_launch: unexpected n_in %d / ws_size %zu (need %zu)\n", n_in, ws_size, (size_t)WS_END); grid_blocks = -1; return; }
        int dev = 0, cus = 0, per_cu = 0;
        hipGetDevice(&dev);
        hipDeviceGetAttribute(&cus, hipDeviceAttributeMultiprocessorCount, dev);
        if (hipFuncSetAttribute((const void*)mega, hipFuncAttributeMaxDynamicSharedMemorySize, LDS_BYTES) != hipSuccess) { fprintf(stderr, "kernel_launch: hipFuncSetAttribute failed\n"); grid_blocks = -1; return; }
        hipOccupancyMaxActiveBlocksPerMultiprocessor(&per_cu, (const void*)mega, 512, LDS_BYTES);
        if (per_cu < 1) { fprintf(stderr, "kernel_launch: occupancy query says %d blocks/CU\n", per_cu); per_cu = 1; }
        grid_blocks = cus * per_cu;
        grid_blocks &= ~7;
        fprintf(stderr, "kernel_launch: grid %d (cus %d x %d)\n", grid_blocks, cus, per_cu);
    }
    if (grid_blocks < 0) return;
    Params p{};
    for (int i = 0; i < 27; ++i) p.in[i] = (const float*)d_in[i];
    p.out = (float*)d_out; p.ws = (unsigned char*)d_ws; p.ph_lo = 0; p.ph_hi = 1 << 20;
    if (hipMemsetAsync((char*)d_ws + WS_BAR, 0, 1024, stream) != hipSuccess) { fprintf(stderr, "kernel_launch: memset failed\n"); return; }
    void* args[] = {&p};
    hipError_t e = hipLaunchCooperativeKernel((const void*)mega, dim3(grid_blocks), dim3(512), args, LDS_BYTES, stream);
    if (e != hipSuccess) fprintf(stderr, "cooperative launch failed: %s (grid %d)\n", hipGetErrorString(e), grid_blocks);
}
```
